# Optimizing an MI355X kernel written in HIP

```python
import jax
import jax.numpy as jnp
from jax import lax
import numpy as np

D_MODEL = 2048
BATCH = 1
SEQ = 8192
DEPTH = 4
DEC_BATCH = 16
DEC_SEQ = 64
PAST_LEN = 2048

CHUNK = 64
A_WIDTH = D_MODEL // 2
A_HEADS = 8
A_DIM = A_WIDTH // A_HEADS
A_BLOCK = 128
B_HEAD_DIM = 64
B_WIDTH = D_MODEL // 2
B_HEADS = B_WIDTH // B_HEAD_DIM
SB_QBLOCK = 128
EVEN_IN = 2 * A_WIDTH + 3 * B_WIDTH
EVEN_MIX = A_WIDTH + B_WIDTH
C_HEAD_DIM = 64
C_HEADS = D_MODEL // C_HEAD_DIM
C_DECAY_LORA = 96
C_ICLR_LORA = 96
C_VRES_LORA = 64
C_GATE_LORA = 256
C_GN_EPS = 64e-5
D_FF = ((8 * D_MODEL // 3 + 255) // 256) * 256
CONV_W = 3
PLE_DIM = 256
LN_EPS = 1e-5
DN_ALPHA = (2 * DEPTH) ** 0.25
DN_BETA = (8 * DEPTH) ** -0.25
N_EVEN = (DEPTH + 1) // 2
N_ODD = DEPTH // 2

kernel_name = 'streaming_gmlp_stickbreak_rwkv7_convffn'


def _layernorm(x, g, b, eps=LN_EPS):
    xf = x.astype(jnp.float32)
    mu = xf.mean(-1, keepdims=True)
    var = jnp.square(xf - mu).mean(-1, keepdims=True)
    return ((xf - mu) * lax.rsqrt(var + eps) * g + b).astype(x.dtype)


def _chunk_mask(n):
    i = jnp.arange(n)
    return (i[:, None] // CHUNK) >= (i[None, :] // CHUNK)


def _spatial_gate(u, vn, w_s, b_s):
    n = u.shape[2]
    w = jnp.where(_chunk_mask(n)[None], w_s[:, :n, :n], 0.0)
    mixed = jnp.einsum('hts,bnshc->bnthc', w, vn) + b_s[:, :n].T[None, None, :, :, None]
    return u * mixed


def _even_project(x, w_in, lnv_g, lnv_b):
    bsz, t, _ = x.shape
    h = x @ w_in
    z_a = jax.nn.gelu(h[..., :2 * A_WIDTH])
    u = z_a[..., :A_WIDTH]
    va = _layernorm(z_a[..., A_WIDTH:], lnv_g, lnv_b)
    o = 2 * A_WIDTH
    q = h[..., o:o + B_WIDTH].reshape(bsz, t, B_HEADS, B_HEAD_DIM)
    k = h[..., o + B_WIDTH:o + 2 * B_WIDTH].reshape(bsz, t, B_HEADS, B_HEAD_DIM)
    v = h[..., o + 2 * B_WIDTH:].reshape(bsz, t, B_HEADS, B_HEAD_DIM)
    return u, va, q, k, v


def _stick_breaking(q, k, v, q_pos):
    f32 = jnp.float32
    z = jnp.einsum('bqhd,bkhd->bhqk', q.astype(f32), k.astype(f32)) * (B_HEAD_DIM ** -0.5)
    k_pos = jnp.arange(k.shape[1])
    mask = k_pos[None, :] < q_pos[:, None]
    log_fail = jnp.where(mask, jax.nn.log_sigmoid(-z), 0.0)
    incl = lax.cumsum(log_fail, axis=3, reverse=True)
    after = jnp.concatenate([incl[..., 1:], jnp.zeros_like(incl[..., :1])], axis=-1)
    wts = jnp.where(mask, jnp.exp(jax.nn.log_sigmoid(z) + after), 0.0)
    return jnp.einsum('bhqk,bkhd->bqhd', wts, v.astype(f32)).astype(v.dtype)


def _stick_breaking_prompt(q, k, v):
    bsz, t, h, d = q.shape
    nb = t // SB_QBLOCK
    qb = q.reshape(bsz, nb, SB_QBLOCK, h, d).transpose(1, 0, 2, 3, 4)
    starts = jnp.arange(nb) * SB_QBLOCK

    def one_block(args):
        qi, s = args
        return _stick_breaking(qi, k, v, s + jnp.arange(SB_QBLOCK))

    out = lax.map(one_block, (qb, starts))
    return out.transpose(1, 0, 2, 3, 4).reshape(bsz, t, h, d)


def _even_mixer_prompt(x, w_in, lnv_g, lnv_b, w_s, b_s, w_o):
    bsz, t, _ = x.shape
    u, va, q, k, v = _even_project(x, w_in, lnv_g, lnv_b)
    nb = t // A_BLOCK
    blk = lambda a: a.reshape(bsz, nb, A_BLOCK, A_HEADS, A_DIM)
    a_out = _spatial_gate(blk(u), blk(va), w_s, b_s).reshape(bsz, t, A_WIDTH)
    b_out = _stick_breaking_prompt(q, k, v).reshape(bsz, t, B_WIDTH)
    out = jnp.concatenate([a_out, b_out], axis=-1) @ w_o
    return out, k, v


def _even_mixer_sample(x, k_cache, v_cache, w_in, lnv_g, lnv_b, w_s, b_s, w_o):
    bsz, t, _ = x.shape
    u, va, q, k, v = _even_project(x, w_in, lnv_g, lnv_b)
    blk = lambda a: a.reshape(bsz, 1, t, A_HEADS, A_DIM)
    a_out = _spatial_gate(blk(u), blk(va), w_s, b_s).reshape(bsz, t, A_WIDTH)
    past = k_cache.shape[1]
    k_all = jnp.concatenate([k_cache.astype(k.dtype), k], axis=1)
    v_all = jnp.concatenate([v_cache.astype(v.dtype), v], axis=1)
    b_out = _stick_breaking(q, k_all, v_all, past + jnp.arange(t)).reshape(bsz, t, B_WIDTH)
    out = jnp.concatenate([a_out, b_out], axis=-1) @ w_o
    return out, k, v, va.reshape(bsz, t, A_HEADS, A_DIM)


def _wkv7_scan(r, w, k, v, a, b, s0):
    f32 = jnp.float32

    def step(s, inp):
        r_t, w_t, k_t, v_t, a_t, b_t = inp
        sa = jnp.einsum('bhij,bhj->bhi', s, a_t)
        s = s * w_t[:, :, None, :] + sa[..., None] * b_t[:, :, None, :] + v_t[..., None] * k_t[:, :, None, :]
        return s, jnp.einsum('bhij,bhj->bhi', s, r_t)

    tm = lambda a_: jnp.moveaxis(a_.astype(f32), 1, 0)
    s_fin, y = lax.scan(step, s0.astype(f32), (tm(r), tm(w), tm(k), tm(v), tm(a), tm(b)))
    return jnp.moveaxis(y, 0, 1), s_fin


def _rwkv7(x, x_last, s0, v_first, vres, mu, w_r, w_k, w_v, w_o, w0, w1, w2,
           a0, a1, a2, g1, g2, k_k, k_a, r_k, gn_g, gn_b):
    bsz, t, d = x.shape
    f32 = jnp.float32
    x_prev = jnp.concatenate([x_last[:, None, :].astype(x.dtype), x[:, :-1]], axis=1)
    xx = x_prev - x
    xr, xw, xk, xv, xa, xg = (x + xx * mu[j] for j in range(6))
    r = xr @ w_r
    k = xk @ w_k
    v = xv @ w_v
    log_w = -jax.nn.softplus(-(w0 + jnp.tanh(xw @ w1) @ w2)) - 0.5
    if vres is None:
        v_first = v
    else:
        v0, v1, v2 = vres
        v = v + (v_first - v) * jax.nn.sigmoid(v0 + (xv @ v1) @ v2)
    a = jax.nn.sigmoid(a0 + (xa @ a1) @ a2)
    g = jax.nn.sigmoid(xg @ g1) @ g2
    hv = lambda z: z.astype(f32).reshape(bsz, t, C_HEADS, C_HEAD_DIM)
    kk = hv(k * k_k)
    kk = kk / jnp.maximum(jnp.sqrt(jnp.sum(kk * kk, axis=-1, keepdims=True)), 1e-12)
    k = k * (1 + (a - 1) * k_a)
    rh, kh, vh, ah = hv(r), hv(k), hv(v), hv(a)
    decay = jnp.exp(-jnp.exp(hv(log_w)))
    y, s_fin = _wkv7_scan(rh, decay, kh, vh, -kk, kk * ah, s0)
    mu_y = y.mean(-1, keepdims=True)
    var_y = jnp.square(y - mu_y).mean(-1, keepdims=True)
    y = ((y - mu_y) * lax.rsqrt(var_y + C_GN_EPS)).reshape(bsz, t, d) * gn_g + gn_b
    bonus = jnp.sum(rh * kh * r_k, axis=-1, keepdims=True) * vh
    y = y + bonus.reshape(bsz, t, d)
    out = (y * g).astype(x.dtype) @ w_o
    return out, s_fin, x[:, -1], v_first


def _conv_ffn(x, conv_prev, w_in, conv_w, conv_b, w_out):
    t = x.shape[1]
    h = x @ w_in
    hg, hu = h[..., :D_FF], h[..., D_FF:]
    hp = jnp.concatenate([conv_prev.astype(hg.dtype), hg], axis=1)
    hc = conv_b
    for j in range(CONV_W):
        hc = hc + hp[:, j:j + t] * conv_w[j]
    out = (jax.nn.gelu(hc) * hu) @ w_out
    return out, hp[:, t:]


def _trunk(x, p, W, sb_k_cache, sb_v_cache, wkv0, shift0, conv0):
    is_prompt = sb_k_cache is None
    new_k, new_v, new_va, new_wkv, new_shift, new_conv = [], [], [], [], [], []
    v_first = None
    for i in range(DEPTH):
        j = i // 2
        if i % 2 == 0:
            args = (W['even_w_in'][j], W['even_lnv_g'][j], W['even_lnv_b'][j],
                    W['even_w_s'][j], W['even_b_s'][j], W['even_w_o'][j])
            if is_prompt:
                mix, k, v = _even_mixer_prompt(x, *args)
            else:
                mix, k, v, va = _even_mixer_sample(x, sb_k_cache[j], sb_v_cache[j], *args)
                new_va.append(va)
            new_k.append(k)
            new_v.append(v)
        else:
            vres = None if j == 0 else (W['c_v0'][j - 1], W['c_v1'][j - 1], W['c_v2'][j - 1])
            mix, s_fin, last, v_first = _rwkv7(
                x, shift0[j], wkv0[j], v_first, vres, W['c_mu'][j], W['c_w_r'][j], W['c_w_k'][j],
                W['c_w_v'][j], W['c_w_o'][j], W['c_w0'][j], W['c_w1'][j], W['c_w2'][j],
                W['c_a0'][j], W['c_a1'][j], W['c_a2'][j], W['c_g1'][j], W['c_g2'][j],
                W['c_k_k'][j], W['c_k_a'][j], W['c_r_k'][j], W['c_gn_g'][j], W['c_gn_b'][j])
            new_wkv.append(s_fin)
            new_shift.append(last)
        x = _layernorm(DN_ALPHA * x + mix, W['ln1_g'][i], W['ln1_b'][i])
        f, conv_rows = _conv_ffn(x, conv0[i], W['ffn_w_in'][i], W['ffn_conv_w'][i],
                                 W['ffn_conv_b'][i], W['ffn_w_out'][i])
        new_conv.append(conv_rows)
        x = _layernorm(DN_ALPHA * x + f, W['ln2_g'][i], W['ln2_b'][i])
        x = x + jax.nn.sigmoid(x @ W['ple_gate'][i]) * (p[i] @ W['ple_proj'][i])
    st = lambda l: jnp.stack(l) if l else None
    return x, st(new_k), st(new_v), st(new_va), st(new_wkv), st(new_shift), st(new_conv)


def setup_inputs(seed: int = 0) -> dict:
    key = jax.random.key(seed)
    keys = jax.random.split(key, 64)
    ctr = [0]

    def nk():
        kk = keys[ctr[0]]
        ctr[0] += 1
        return kk

    def nrm(shape, scale=1.0):
        return jax.random.normal(nk(), shape, jnp.float32) * scale

    def gain(shape):
        return 1.0 + nrm(shape, 0.02)

    f = D_MODEL ** -0.5
    in_col_scale = jnp.concatenate([jnp.ones((2 * A_WIDTH + 2 * B_WIDTH,), jnp.float32),
                                    jnp.full((B_WIDTH,), DN_BETA, jnp.float32)])
    return {
        'x_prompt': nrm((BATCH, SEQ, D_MODEL)),
        'x_sample': nrm((DEC_BATCH, DEC_SEQ, D_MODEL)),
        'cache_sb_k': nrm((N_EVEN, DEC_BATCH, PAST_LEN, B_HEADS, B_HEAD_DIM)),
        'cache_sb_v': nrm((N_EVEN, DEC_BATCH, PAST_LEN, B_HEADS, B_HEAD_DIM), DN_BETA),
        'state_rwkv_wkv': nrm((N_ODD, DEC_BATCH, C_HEADS, C_HEAD_DIM, C_HEAD_DIM), 0.3),
        'state_rwkv_shift': nrm((N_ODD, DEC_BATCH, D_MODEL)),
        'state_ffn_conv': nrm((DEPTH, DEC_BATCH, CONV_W - 1, D_FF), DN_BETA),
        'p_prompt': nrm((DEPTH, BATCH, SEQ, PLE_DIM)),
        'p_sample': nrm((DEPTH, DEC_BATCH, DEC_SEQ, PLE_DIM)),
        'even_w_in': nrm((N_EVEN, D_MODEL, EVEN_IN), f) * in_col_scale,
        'even_lnv_g': gain((N_EVEN, A_WIDTH)),
        'even_lnv_b': nrm((N_EVEN, A_WIDTH), 0.02),
        'even_w_s': nrm((N_EVEN, A_HEADS, A_BLOCK, A_BLOCK), 0.5 * A_BLOCK ** -0.5),
        'even_b_s': gain((N_EVEN, A_HEADS, A_BLOCK)),
        'even_w_o': nrm((N_EVEN, EVEN_MIX, D_MODEL), DN_BETA * EVEN_MIX ** -0.5),
        'c_mu': jax.random.uniform(nk(), (N_ODD, 6, D_MODEL), jnp.float32),
        'c_w_r': nrm((N_ODD, D_MODEL, D_MODEL), f),
        'c_w_k': nrm((N_ODD, D_MODEL, D_MODEL), f),
        'c_w_v': nrm((N_ODD, D_MODEL, D_MODEL), f * DN_BETA),
        'c_w_o': nrm((N_ODD, D_MODEL, D_MODEL), f * DN_BETA),
        'c_w0': nrm((N_ODD, D_MODEL), 1.0),
        'c_w1': nrm((N_ODD, D_MODEL, C_DECAY_LORA), f),
        'c_w2': nrm((N_ODD, C_DECAY_LORA, D_MODEL), 0.5 * C_DECAY_LORA ** -0.5),
        'c_a0': nrm((N_ODD, D_MODEL), 0.5),
        'c_a1': nrm((N_ODD, D_MODEL, C_ICLR_LORA), f),
        'c_a2': nrm((N_ODD, C_ICLR_LORA, D_MODEL), 0.5 * C_ICLR_LORA ** -0.5),
        'c_v0': nrm((N_ODD - 1, D_MODEL), 0.5),
        'c_v1': nrm((N_ODD - 1, D_MODEL, C_VRES_LORA), f),
        'c_v2': nrm((N_ODD - 1, C_VRES_LORA, D_MODEL), 0.5 * C_VRES_LORA ** -0.5),
        'c_g1': nrm((N_ODD, D_MODEL, C_GATE_LORA), f),
        'c_g2': nrm((N_ODD, C_GATE_LORA, D_MODEL), C_GATE_LORA ** -0.5),
        'c_k_k': 0.85 + nrm((N_ODD, D_MODEL), 0.02),
        'c_k_a': gain((N_ODD, D_MODEL)),
        'c_r_k': nrm((N_ODD, C_HEADS, C_HEAD_DIM), 0.1),
        'c_gn_g': gain((N_ODD, D_MODEL)),
        'c_gn_b': nrm((N_ODD, D_MODEL), 0.02),
        'ffn_w_in': nrm((DEPTH, D_MODEL, 2 * D_FF), f * DN_BETA),
        'ffn_conv_w': nrm((DEPTH, CONV_W, D_FF), CONV_W ** -0.5),
        'ffn_conv_b': nrm((DEPTH, D_FF), 0.02),
        'ffn_w_out': nrm((DEPTH, D_FF, D_MODEL), DN_BETA * D_FF ** -0.5),
        'ln1_g': gain((DEPTH, D_MODEL)),
        'ln1_b': nrm((DEPTH, D_MODEL), 0.02),
        'ln2_g': gain((DEPTH, D_MODEL)),
        'ln2_b': nrm((DEPTH, D_MODEL), 0.02),
        'ple_proj': nrm((DEPTH, PLE_DIM, D_MODEL), PLE_DIM ** -0.5),
        'ple_gate': nrm((DEPTH, D_MODEL, D_MODEL), f),
    }


def reference(x_prompt, x_sample, cache_sb_k, cache_sb_v, state_rwkv_wkv, state_rwkv_shift,
              state_ffn_conv, p_prompt, p_sample, even_w_in, even_lnv_g, even_lnv_b, even_w_s,
              even_b_s, even_w_o, c_mu, c_w_r, c_w_k, c_w_v, c_w_o, c_w0, c_w1, c_w2, c_a0, c_a1,
              c_a2, c_v0, c_v1, c_v2, c_g1, c_g2, c_k_k, c_k_a, c_r_k, c_gn_g, c_gn_b, ffn_w_in,
              ffn_conv_w, ffn_conv_b, ffn_w_out, ln1_g, ln1_b, ln2_g, ln2_b, ple_proj, ple_gate):
    W = dict(even_w_in=even_w_in, even_lnv_g=even_lnv_g, even_lnv_b=even_lnv_b, even_w_s=even_w_s,
             even_b_s=even_b_s, even_w_o=even_w_o, c_mu=c_mu, c_w_r=c_w_r, c_w_k=c_w_k,
             c_w_v=c_w_v, c_w_o=c_w_o, c_w0=c_w0, c_w1=c_w1, c_w2=c_w2, c_a0=c_a0, c_a1=c_a1,
             c_a2=c_a2, c_v0=c_v0, c_v1=c_v1, c_v2=c_v2, c_g1=c_g1, c_g2=c_g2, c_k_k=c_k_k,
             c_k_a=c_k_a, c_r_k=c_r_k, c_gn_g=c_gn_g, c_gn_b=c_gn_b, ffn_w_in=ffn_w_in,
             ffn_conv_w=ffn_conv_w, ffn_conv_b=ffn_conv_b, ffn_w_out=ffn_w_out, ln1_g=ln1_g,
             ln1_b=ln1_b, ln2_g=ln2_g, ln2_b=ln2_b, ple_proj=ple_proj, ple_gate=ple_gate)
    bp = x_prompt.shape[0]
    wkv_zero = jnp.zeros((N_ODD, bp, C_HEADS, C_HEAD_DIM, C_HEAD_DIM), jnp.float32)
    shift_zero = jnp.zeros((N_ODD, bp, D_MODEL), x_prompt.dtype)
    conv_zero = jnp.zeros((DEPTH, bp, CONV_W - 1, D_FF), x_prompt.dtype)
    y_prompt, k_p, v_p, _, wkv_p, shift_p, conv_p = _trunk(
        x_prompt, p_prompt, W, None, None, wkv_zero, shift_zero, conv_zero)
    y_sample, k_s, v_s, va_s, wkv_s, shift_s, conv_s = _trunk(
        x_sample, p_sample, W, cache_sb_k, cache_sb_v, state_rwkv_wkv, state_rwkv_shift, state_ffn_conv)
    return (y_prompt, y_sample, k_p, v_p, wkv_p, shift_p, conv_p, k_s, v_s, va_s, wkv_s, shift_s, conv_s)
```

```cpp
#include <hip/hip_runtime.h>
#include <cstdio>
#include <cstdint>

#ifndef MK_ONE_LAUNCH
#define MK_ONE_LAUNCH 0
#endif

namespace pg8 {
#define PG8_LAS __attribute__((address_space(3)))
typedef unsigned short bf16_t;
typedef short bf16x8 __attribute__((ext_vector_type(8)));
typedef float f32x4 __attribute__((ext_vector_type(4)));
typedef unsigned u32x4 __attribute__((ext_vector_type(4)));
typedef unsigned u32x2 __attribute__((ext_vector_type(2)));
constexpr int BM = 256, BK = 64, HALF = 128, HTB = HALF * BK * 2  , STAGE_BYTES = 8 * HTB, NXCD = 8, WGM = 8;

__host__ __device__ __forceinline__ int lds_byte(int r, int c) { const int st = (r >> 4) * 2 + (c >> 5), rr = r & 15, cc = c & 31, ob = rr * 64 + cc * 2; return st * 1024 + (ob ^ (((ob >> 9) & 1) << 5)); }
__host__ __device__ __forceinline__ void stage_rc(int b, int& R, int& C) { const int st = b / 1024, sb = b % 1024, swz = sb ^ (((sb >> 9) & 1) << 5); R = (st >> 1) * 16 + swz / 64; C = (st & 1) * 32 + (swz % 64) / 2; }
__host__ __device__ __forceinline__ int perm32(int rho) { const int n = rho >> 4, i = rho & 15; return 8 * (i >> 2) + 4 * n + (i & 3); }

struct Unit { int pm, pn; };
struct Gemm { const bf16_t* A; const bf16_t* Bt; int M, N, K, lda; unsigned long long asel0, asel1; size_t asel_stride; };
__device__ __forceinline__ const char* a_base(const Gemm& g, const Unit& u) {
    size_t off = 0;
    if (g.asel_stride) { const unsigned sel = (unsigned)(((u.pn < 16) ? (g.asel0 >> (4 * u.pn)) : (g.asel1 >> (4 * (u.pn & 15)))) & 15ull); off = (size_t)sel * g.asel_stride; }
    return (const char*)(g.A + off) + (size_t)u.pm * ((size_t)BM * g.lda * 2);
}

struct StaticOrder {
    int nM, nN, nwg, G, c;
    __host__ __device__ void init(int M, int N, int G_, int c_) { nM = M / BM; nN = N / BM; nwg = nM * nN; G = G_; c = c_; }
    __host__ __device__ bool next(int i, Unit& u) const {
        const long L = (long)i * G + c; if (L >= nwg) return false;
        int wgid = (int)L; { const int q = nwg / NXCD, r = nwg % NXCD, xcd = wgid % NXCD, off = wgid / NXCD; wgid = (xcd < r ? xcd * (q + 1) : r * (q + 1) + (xcd - r) * q) + off; }
        const int nig = WGM * nN, gid = wgid / nig, fm = gid * WGM, gsz = (nM - fm) < WGM ? (nM - fm) : WGM;
        u.pm = fm + ((wgid % nig) % gsz); u.pn = (wgid % nig) / gsz; return true;
    }
    __device__ __forceinline__ void a_ready(const Unit&) const {}
    __device__ __forceinline__ void done(const Unit&) const {}
};

__device__ __forceinline__ unsigned cvt_pk_bf16(float lo, float hi) { unsigned r; asm volatile("v_cvt_pk_bf16_f32 %0, %1, %2" : "=v"(r) : "v"(lo), "v"(hi)); return r; }

template <class Epi, class Sched, bool ALIGN_EPI = false>
__device__ __forceinline__ void gemm_phase(PG8_LAS unsigned char* lds, const Gemm g, const Sched& S, const Epi& E) {
    int tid_ = threadIdx.x; asm volatile("" : "+v"(tid_));
    const int tid = tid_, wid = __builtin_amdgcn_readfirstlane(tid >> 6), lane = tid & 63, wr = wid >> 2, wc = wid & 3, fr = lane & 15, fq = lane >> 4;
    const int K = g.K, nt = K / BK, lda = g.lda;
    unsigned voffA[2], voffB[2];
#pragma unroll
    for (int i = 0; i < 2; ++i) { int R, C; stage_rc(tid * 16 + i * 8192, R, C); const int Rb = Epi::PERM ? ((R & ~31) + perm32(R & 31)) : R;
        voffA[i] = (unsigned)(R * lda + C) * 2u; voffB[i] = (unsigned)(Rb * K + C) * 2u; }
    const size_t kstep = (size_t)(BK * 2);
    const size_t hstepA = (size_t)HALF * lda * 2, hstepB = (size_t)HALF * K * 2;
    const size_t tstepB = 2 * hstepB;
    const unsigned ldsw = (unsigned)wid * 1024u;
    const int aoff = lds_byte(wr * 64 + fr, fq * 8), boff = lds_byte(wc * 32 + fr, fq * 8);
#define PG8_SA(b, h) (((b) * 2 + (h)) * HTB)
#define PG8_SB(b, h) ((4 + (b) * 2 + (h)) * HTB)
#define PG8_STAGE(bufoff, gbase, voff) do { _Pragma("unroll") for (int _i = 0; _i < 2; ++_i) \
        __builtin_amdgcn_global_load_lds((const unsigned*)((const char*)(gbase) + (voff)[_i]), (PG8_LAS unsigned*)(lds + (bufoff) + ldsw + _i * 8192), 16, 0, 0); } while (0)
#define PG8_LDA(dst, b, h) do { _Pragma("unroll") for (int m = 0; m < 4; ++m) _Pragma("unroll") for (int k = 0; k < 2; ++k) dst[m][k] = *(const PG8_LAS bf16x8*)(lds + PG8_SA(b, h) + aoff + m * 2048 + k * 1024); } while (0)
#define PG8_LDB(dst, b, h) do { _Pragma("unroll") for (int n = 0; n < 2; ++n) _Pragma("unroll") for (int k = 0; k < 2; ++k) dst[n][k] = *(const PG8_LAS bf16x8*)(lds + PG8_SB(b, h) + boff + n * 2048 + k * 1024); } while (0)
#define PG8_MMA(ai, bj, At, Bt) do { __builtin_amdgcn_s_setprio(1); _Pragma("unroll") for (int m = 0; m < 4; ++m) _Pragma("unroll") for (int n = 0; n < 2; ++n) _Pragma("unroll") for (int k = 0; k < 2; ++k) \
        acc[ai][bj][m][n] = __builtin_amdgcn_mfma_f32_16x16x32_bf16(Bt[n][k], At[m][k], acc[ai][bj][m][n], 0, 0, 0); __builtin_amdgcn_s_setprio(0); } while (0)
#define PG8_WAIT_V(n) asm volatile("s_waitcnt vmcnt(" #n ")" ::: "memory")
#define PG8_WAIT_L(n) asm volatile("s_waitcnt lgkmcnt(" #n ")" ::: "memory")
#define PG8_BAR __builtin_amdgcn_s_barrier()
#define PG8_SCHED __builtin_amdgcn_sched_barrier(0)
    Unit cur, nxt; int ui = 0;
    if (!S.next(0, cur)) return;
    f32x4 acc[2][2][4][2];
#pragma unroll
    for (int a = 0; a < 2; ++a)
#pragma unroll
        for (int b = 0; b < 2; ++b)
#pragma unroll
            for (int m = 0; m < 4; ++m)
#pragma unroll
                for (int n = 0; n < 2; ++n) acc[a][b][m][n] = (f32x4){0.f, 0.f, 0.f, 0.f};
    bf16x8 At[4][2], B0[2][2], B1[2][2];
    const char* cA = a_base(g, cur); const char* cB = (const char*)g.Bt + (size_t)cur.pn * tstepB;
    S.a_ready(cur);
    PG8_STAGE(PG8_SB(0, 0), cB, voffB); PG8_STAGE(PG8_SB(0, 1), cB + hstepB, voffB); PG8_STAGE(PG8_SA(0, 0), cA, voffA); PG8_STAGE(PG8_SA(0, 1), cA + hstepA, voffA);
    if (wr == 1) PG8_BAR;
    PG8_WAIT_V(2); PG8_BAR;
    PG8_STAGE(PG8_SB(1, 0), cB + kstep, voffB); PG8_STAGE(PG8_SA(1, 0), cA + kstep, voffA); PG8_STAGE(PG8_SB(1, 1), cB + hstepB + kstep, voffB);
    PG8_WAIT_V(6); PG8_BAR;
    for (;;) {
        const bool has_next = S.next(ui + 1, nxt);
        const char* nA = has_next ? a_base(g, nxt) : cA; const char* nB = has_next ? (const char*)g.Bt + (size_t)nxt.pn * tstepB : cB;
#pragma unroll 1
        for (int t = 0; t < nt; t += 2) {
            const bool last = (t == nt - 2);
            const char* a1 = cA + (size_t)(t + 1) * kstep;
            const char* a2 = last ? nA : cA + (size_t)(t + 2) * kstep; const char* b2 = last ? nB : cB + (size_t)(t + 2) * kstep;
            const char* a3 = a2 + kstep; const char* b3 = b2 + kstep;
            if (last && has_next) S.a_ready(nxt);
            PG8_LDB(B0, 0, 0); PG8_LDB(B1, 0, 1); PG8_SCHED; PG8_LDA(At, 0, 0); PG8_STAGE(PG8_SA(1, 1), a1 + hstepA, voffA);
            PG8_WAIT_V(8); PG8_WAIT_L(0); PG8_BAR; PG8_MMA(0, 0, At, B0); PG8_MMA(0, 1, At, B1); PG8_BAR; PG8_SCHED;
            PG8_LDA(At, 0, 1); PG8_STAGE(PG8_SB(0, 0), b2, voffB); PG8_STAGE(PG8_SB(0, 1), b2 + hstepB, voffB); PG8_STAGE(PG8_SA(0, 0), a2, voffA);
            PG8_WAIT_V(8); PG8_WAIT_L(0); PG8_BAR; PG8_MMA(1, 0, At, B0); PG8_MMA(1, 1, At, B1); PG8_BAR; PG8_SCHED;
            PG8_LDB(B0, 1, 0); PG8_LDB(B1, 1, 1); PG8_SCHED; PG8_LDA(At, 1, 0); PG8_STAGE(PG8_SA(0, 1), a2 + hstepA, voffA);
            PG8_WAIT_V(8); PG8_WAIT_L(0); PG8_BAR; PG8_MMA(0, 0, At, B0); PG8_MMA(0, 1, At, B1); PG8_BAR; PG8_SCHED;
            PG8_LDA(At, 1, 1); PG8_STAGE(PG8_SB(1, 0), b3, voffB); PG8_STAGE(PG8_SB(1, 1), b3 + hstepB, voffB); PG8_STAGE(PG8_SA(1, 0), a3, voffA);
            PG8_WAIT_V(8); PG8_WAIT_L(0); PG8_BAR; PG8_MMA(1, 0, At, B0); PG8_MMA(1, 1, At, B1); PG8_BAR; PG8_SCHED;
        }
        if constexpr (ALIGN_EPI) { if (wr == 0) PG8_BAR; }
        E(acc, cur, wr, wc, fr, fq); S.done(cur);
        if (!has_next) break;
#pragma unroll
        for (int a = 0; a < 2; ++a)
#pragma unroll
            for (int b = 0; b < 2; ++b)
#pragma unroll
                for (int m = 0; m < 4; ++m)
#pragma unroll
                    for (int n = 0; n < 2; ++n) acc[a][b][m][n] = (f32x4){0.f, 0.f, 0.f, 0.f};
        cur = nxt; cA = nA; cB = nB; ++ui;
        if constexpr (ALIGN_EPI) { if (wr == 1) PG8_BAR; }
    }
    PG8_WAIT_V(0);
    if constexpr (!ALIGN_EPI) { if (wr == 0) PG8_BAR; }
    PG8_BAR;
#undef PG8_SA
#undef PG8_SB
#undef PG8_STAGE
#undef PG8_LDA
#undef PG8_LDB
#undef PG8_MMA
#undef PG8_WAIT_V
#undef PG8_WAIT_L
#undef PG8_BAR
#undef PG8_SCHED
}
}

constexpr int NWAVES = 8, NTHREADS = 512;
constexpr int D = 2048, MP = 8192, MS = 1024, M = MP + MS;
constexpr int AW = 1024, EVEN_IN = 5120, DFF = 5632, PLE = 256;
constexpr int N_O1 = 7168, N_O2 = 8192;
constexpr float ALPHA = 1.6817928305074292f;
constexpr float LN_EPS = 1e-5f, GN_EPS = 64e-5f;
constexpr float SB_THRESH = 100.0f;

constexpr size_t OFF_YP = 0, OFF_YS = 16777216, OFF_KP = 18874368, OFF_VP = 35651584, OFF_WKVP = 52428800, OFF_SHP = 52690944, OFF_CVP = 52695040,
                 OFF_KS = 52740096, OFF_VS = 54837248, OFF_VAS = 56934400, OFF_WKVS = 59031552, OFF_SHS = 63225856, OFF_CVS = 63291392, OUT_END = 64012288;

enum { I_XP = 0, I_XS, I_CK, I_CV, I_WKV, I_SHIFT, I_CONV, I_PP, I_PS, I_EWIN, I_LNVG, I_LNVB, I_EWS, I_EBS, I_EWO, I_MU, I_CWR, I_CWK, I_CWV, I_CWO, I_W0, I_W1, I_W2,
       I_A0, I_A1, I_A2, I_V0, I_V1, I_V2, I_G1, I_G2, I_KK, I_KA, I_RK, I_GNG, I_GNB, I_FWIN, I_FCW, I_FCB, I_FWOUT, I_LN1G, I_LN1B, I_LN2G, I_LN2B, I_PLEP, I_PLEG, N_IN };

constexpr size_t MiB = 1u << 20;
constexpr size_t WS_CTL = 0, CTL_ZERO_BYTES = 1 * MiB;
constexpr size_t SZ_WIN = 5120ull * 2048 * 2, SZ_W22 = 2048ull * 2048 * 2, SZ_W1T = 7168ull * 2048 * 2, SZ_W2T = 8192ull * 256 * 2, SZ_FIN = 11264ull * 2048 * 2, SZ_FOUT = 2048ull * 5632 * 2, SZ_WP = 2048ull * 256 * 2;
constexpr size_t WS_WIN = 1 * MiB, WS_WOE = WS_WIN + 2 * SZ_WIN, WS_W1T = WS_WOE + 2 * SZ_W22, WS_W2T = WS_W1T + 2 * SZ_W1T, WS_WOC = WS_W2T + 2 * SZ_W2T,
                 WS_FIN = WS_WOC + 2 * SZ_W22, WS_FOUT = WS_FIN + 4 * SZ_FIN, WS_WG = WS_FOUT + 4 * SZ_FOUT, WS_WP = WS_WG + 4 * SZ_W22, WS_WEND = WS_WP + 4 * SZ_WP;
constexpr size_t SZ_X32 = (size_t)M * D * 4, SZ_X16 = (size_t)M * D * 2, SZ_PB = (size_t)M * PLE * 2, SZ_H16 = (size_t)M * 1024 * 2, SZ_FF16 = (size_t)M * DFF * 2, SZ_H1 = (size_t)M * 512 * 2;
constexpr size_t WS_X = WS_WEND, WS_XB = WS_X + SZ_X32, WS_Y = WS_XB + 2 * SZ_X16,
                 WS_PB = WS_Y + SZ_X32, WS_V1 = WS_PB + 4 * SZ_PB, WS_SCR = WS_V1 + SZ_X32;
constexpr size_t WS_U = WS_SCR, WS_ZV = WS_U + SZ_H16, WS_QF = WS_ZV + SZ_H16, WS_AO = WS_QF + 2 * SZ_H16, WS_EVEN_END = WS_AO + SZ_X16;
constexpr size_t WS_MIX = WS_SCR, WS_R = WS_MIX + 6 * SZ_X16, WS_K = WS_R + SZ_X32, WS_V3 = WS_K + SZ_X32, WS_H1 = WS_V3 + SZ_X32, WS_WD = WS_H1 + SZ_H1, WS_AA = WS_WD + SZ_X32,
                 WS_VG = WS_AA + SZ_X16, WS_GG = WS_VG + SZ_X16, WS_YS = WS_GG + SZ_X16, WS_YG = WS_YS + SZ_X32, WS_ODD_END = WS_YG + SZ_X16;
constexpr size_t WS_HG = WS_SCR, WS_HU = WS_HG + SZ_FF16, WS_ACT = WS_HU + SZ_FF16, WS_PPF = WS_ACT + SZ_FF16, WS_FFN_END = WS_PPF + SZ_X32;
constexpr size_t WS_END = WS_ODD_END > WS_FFN_END ? (WS_ODD_END > WS_EVEN_END ? WS_ODD_END : WS_EVEN_END) : (WS_FFN_END > WS_EVEN_END ? WS_FFN_END : WS_EVEN_END);
static_assert(WS_END <= 1568358400ull, "workspace map exceeds the guaranteed d_ws size");
constexpr int CW_BAR = 4096;

constexpr int LDS_BYTES = 147456;
constexpr int LDSCTL_OFF = LDS_BYTES - 256;

#define GAS __attribute__((address_space(1)))
#define LAS __attribute__((address_space(3)))
typedef unsigned short bf16;
typedef unsigned v4u __attribute__((ext_vector_type(4)));
typedef unsigned v2u __attribute__((ext_vector_type(2)));
typedef float f32x4 __attribute__((ext_vector_type(4)));
typedef float f32x2 __attribute__((ext_vector_type(2)));
#define LDS_WAIT() asm volatile("s_waitcnt lgkmcnt(0)" ::: "memory")
#define VM_WAIT() asm volatile("s_waitcnt vmcnt(0)" ::: "memory")
using pg8::cvt_pk_bf16;
__device__ __forceinline__ float bf_lo(unsigned w) { return __uint_as_float(w << 16); }
__device__ __forceinline__ float bf_hi(unsigned w) { return __uint_as_float(w & 0xffff0000u); }
__device__ __forceinline__ float sigmoid_f(float x) { return 1.f / (1.f + __expf(-x)); }
__device__ __forceinline__ float tanh_f(float x) { return 1.f - 2.f / (1.f + __expf(2.f * x)); }
__device__ __forceinline__ float gelu_f(float x) { const float u = 0.7978845608028654f * (x + 0.044715f * x * x * x); return x / (1.f + __expf(-2.f * u)); }
__device__ __forceinline__ f32x4 gelu4(f32x4 v) { return (f32x4){gelu_f(v.x), gelu_f(v.y), gelu_f(v.z), gelu_f(v.w)}; }
__device__ __forceinline__ v2u pk4(f32x4 v) { v2u r; r.x = cvt_pk_bf16(v.x, v.y); r.y = cvt_pk_bf16(v.z, v.w); return r; }
template <int CTRL> __device__ __forceinline__ float dpp_f(float x) { return __builtin_bit_cast(float, __builtin_amdgcn_update_dpp(0, __builtin_bit_cast(int, x), CTRL, 0xF, 0xF, true)); }
__device__ __forceinline__ float reduce8(float x) { x += dpp_f<0xB1>(x); x += dpp_f<0x4E>(x); x += dpp_f<0x141>(x); return x; }
__device__ __forceinline__ float reduce16(float x) { x = reduce8(x); x += dpp_f<0x140>(x); return x; }
__device__ __forceinline__ float wave_sum(float x) { x = reduce16(x); x += __shfl_xor(x, 16); x += __shfl_xor(x, 32); return x; }

#define XLAS LAS
#define XB_TMO      128
#define XB_XCNT(j)  (256  + 64 * (j))
#define XB_XSUB(j)  (1280 + 64 * (j))
#define XB_XGEN(j)  (2304 + 64 * (j))
#define XB_TOP      3328
#define XB_TOPGEN   3392
#define XCD_BAR_WORDS 3456
#define XB_SPIN_CAP (1u << 18)
__device__ __forceinline__ unsigned xb_ld(unsigned* p)              { return __hip_atomic_load(p, __ATOMIC_RELAXED, __HIP_MEMORY_SCOPE_AGENT); }
__device__ __forceinline__ unsigned xb_add(unsigned* p, unsigned v) { return __hip_atomic_fetch_add(p, v, __ATOMIC_RELAXED, __HIP_MEMORY_SCOPE_AGENT); }
__device__ __forceinline__ unsigned xb_xcc_id() { return (unsigned)__builtin_amdgcn_s_getreg((3 << 11) | 20) & 0xFu; }
#define XB_SPIN(cond, bar) do { unsigned _sp = 0; while (cond) { __builtin_amdgcn_s_sleep(1); \
    if ((++_sp & 255u) == 0u) { if (xb_ld(&(bar)[XB_TMO])) break; if (_sp > XB_SPIN_CAP) { atomicAdd(&(bar)[XB_TMO], 1u); break; } } } } while (0)
struct XcdBarrier { unsigned* bar; unsigned x; volatile LAS unsigned* st; };
__device__ __forceinline__ XcdBarrier xcd_barrier_post(unsigned* bar, volatile LAS unsigned* st) {
    XcdBarrier b; b.bar = bar; b.x = xb_xcc_id(); b.st = st;
    if (threadIdx.x == 0) (void)xb_add(&bar[XB_XCNT(b.x)], 1u);
    return b;
}
__device__ __forceinline__ void xcd_barrier_complete(unsigned* bar, unsigned x, unsigned& nloc, unsigned& nx) {
    const unsigned G = gridDim.x * gridDim.y * gridDim.z;
    unsigned sum, cnt, mine, sp = 0u;
    for (;;) {
        sum = 0u; cnt = 0u; mine = 0u;
#pragma unroll
        for (unsigned j = 0; j < 16; ++j) { const unsigned c = xb_ld(&bar[XB_XCNT(j)]); sum += c; cnt += (c > 0u) ? 1u : 0u; mine = (j == x) ? c : mine; }
        if (sum == G) break;
        __builtin_amdgcn_s_sleep(1);
        if ((++sp & 255u) == 0u) { if (xb_ld(&bar[XB_TMO])) break; if (sp > XB_SPIN_CAP) { atomicAdd(&bar[XB_TMO], 1u); break; } }
    }
    nloc = mine > 0u ? mine : 1u; nx = cnt > 0u ? cnt : 1u;
}
__device__ __forceinline__ void xcd_barrier(const XcdBarrier& b) {
    asm volatile("s_waitcnt vmcnt(0)" ::: "memory");
    __syncthreads();
    if (threadIdx.x == 0) {
        unsigned* bar = b.bar;
        __builtin_amdgcn_s_waitcnt(0);
        unsigned nloc = b.st[0], nx = b.st[1];
        if (nloc == 0u) { xcd_barrier_complete(bar, b.x, nloc, nx); b.st[0] = nloc; b.st[1] = nx; }
        const unsigned old = xb_add(&bar[XB_XSUB(b.x)], 1u);
        const unsigned gen = old / nloc;
        if (old + 1u == (gen + 1u) * nloc) {
            __builtin_amdgcn_fence(__ATOMIC_RELEASE, "agent");
            asm volatile("s_waitcnt vmcnt(0)" ::: "memory");
            const unsigned og = xb_add(&bar[XB_TOP], 1u);
            const unsigned tg = og / nx;
            if (og + 1u == (tg + 1u) * nx) xb_add(&bar[XB_TOPGEN], 1u);
            else XB_SPIN(xb_ld(&bar[XB_TOPGEN]) == tg, bar);
            __builtin_amdgcn_fence(__ATOMIC_ACQUIRE, "agent");
            xb_add(&bar[XB_XGEN(b.x)], 1u);
            asm volatile("s_waitcnt vmcnt(0)" ::: "memory");
        } else {
            XB_SPIN(xb_ld(&bar[XB_XGEN(b.x)]) == gen, bar);
            __builtin_amdgcn_fence(__ATOMIC_ACQUIRE, "agent");
            asm volatile("s_waitcnt vmcnt(0)" ::: "memory");
        }
    }
    __syncthreads();
}

struct Args { const float* in[N_IN]; float* out; unsigned char* ws; int ph_lo, ph_hi; };

__device__ __forceinline__ const float* inp(const Args& a, int i) { int k = i; asm volatile("" : "+s"(k)); return a.in[k]; }
__device__ __forceinline__ unsigned char* wsp(const Args& a) { size_t z = 0; asm volatile("" : "+s"(z)); return a.ws + z; }
__device__ __forceinline__ float* outp(const Args& a) { size_t z = 0; asm volatile("" : "+s"(z)); return a.out + z; }

__device__ __forceinline__ bool seq_start(int m) { return m == 0 || (m >= MP && ((m - MP) & 63) == 0); }

template <class F> __device__ __forceinline__ void epi_each(const f32x4 (&acc)[2][2][4][2], const pg8::Unit& u, int wr, int wc, int fr, int fq, F&& f) {
#pragma unroll
    for (int ai = 0; ai < 2; ++ai)
#pragma unroll
        for (int m = 0; m < 4; ++m) { const int row = u.pm * 256 + ai * 128 + wr * 64 + m * 16 + fr;
#pragma unroll
            for (int bj = 0; bj < 2; ++bj)
#pragma unroll
                for (int n = 0; n < 2; ++n) f(row, u.pn * 256 + bj * 128 + wc * 32 + n * 16 + fq * 4, acc[ai][bj][m][n]);
            asm volatile("" ::: "memory"); }
}
template <class F> __device__ __forceinline__ void epi_each8(const f32x4 (&acc)[2][2][4][2], const pg8::Unit& u, int wr, int wc, int fr, int fq, F&& f) {
#pragma unroll
    for (int ai = 0; ai < 2; ++ai)
#pragma unroll
        for (int m = 0; m < 4; ++m) { const int row = u.pm * 256 + ai * 128 + wr * 64 + m * 16 + fr;
#pragma unroll
            for (int bj = 0; bj < 2; ++bj) f(row, u.pn * 256 + bj * 128 + wc * 32 + fq * 8, acc[ai][bj][m][0], acc[ai][bj][m][1]);
            asm volatile("" ::: "memory"); }
}

struct EpiEvenIn {
    static constexpr bool PERM = false;
    bf16* U; bf16* ZV; float* QF; float* out; int j;
    __device__ __forceinline__ void operator()(const f32x4 (&acc)[2][2][4][2], const pg8::Unit& u, int wr, int wc, int fr, int fq) const {
        const int grp = u.pn >> 2;
        if (grp == 0) epi_each(acc, u, wr, wc, fr, fq, [&](int row, int col, f32x4 v) { *(v2u*)(U + (size_t)row * 1024 + col) = pk4(gelu4(v)); });
        else if (grp == 1) epi_each(acc, u, wr, wc, fr, fq, [&](int row, int col, f32x4 v) { *(v2u*)(ZV + (size_t)row * 1024 + (col - 1024)) = pk4(gelu4(v)); });
        else if (grp == 2) epi_each(acc, u, wr, wc, fr, fq, [&](int row, int col, f32x4 v) { *(f32x4*)(QF + (size_t)row * 1024 + (col - 2048)) = v; });
        else { float* bp = out + (grp == 3 ? OFF_KP : OFF_VP) + (size_t)j * MP * 1024; float* bs = out + (grp == 3 ? OFF_KS : OFF_VS) + (size_t)j * MS * 1024; const int c0 = grp == 3 ? 3072 : 4096;
            epi_each(acc, u, wr, wc, fr, fq, [&](int row, int col, f32x4 v) { float* d = row < MP ? bp + (size_t)row * 1024 : bs + (size_t)(row - MP) * 1024; *(f32x4*)(d + (col - c0)) = v; }); }
    }
};
struct EpiResid {
    static constexpr bool PERM = false;
    const float* X; float* Y;
    __device__ __forceinline__ void operator()(const f32x4 (&acc)[2][2][4][2], const pg8::Unit& u, int wr, int wc, int fr, int fq) const {
        epi_each(acc, u, wr, wc, fr, fq, [&](int row, int col, f32x4 v) { const size_t o = (size_t)row * D + col; const f32x4 x = *(const f32x4*)(X + o); *(f32x4*)(Y + o) = x * ALPHA + v; });
    }
};
struct EpiFfnIn {
    static constexpr bool PERM = true;
    bf16* HG; bf16* HU; float* out; int layer;
    __device__ __forceinline__ void operator()(const f32x4 (&acc)[2][2][4][2], const pg8::Unit& u, int wr, int wc, int fr, int fq) const {
        if (u.pn < 22) { float* cp = out + OFF_CVP + (size_t)layer * 2 * DFF; float* cs = out + OFF_CVS + (size_t)layer * 16 * 2 * DFF;
            epi_each8(acc, u, wr, wc, fr, fq, [&](int row, int col, f32x4 v0, f32x4 v1) {
                v4u w; w.x = cvt_pk_bf16(v0.x, v0.y); w.y = cvt_pk_bf16(v0.z, v0.w); w.z = cvt_pk_bf16(v1.x, v1.y); w.w = cvt_pk_bf16(v1.z, v1.w);
                *(v4u*)(HG + (size_t)row * DFF + col) = w;
                float* d = nullptr;
                if (row < MP) { if (row >= MP - 2) d = cp + (size_t)(row - (MP - 2)) * DFF; }
                else { const int t = (row - MP) & 63, b = (row - MP) >> 6; if (t >= 62) d = cs + ((size_t)b * 2 + (t - 62)) * DFF; }
                if (d) { *(f32x4*)(d + col) = v0; *(f32x4*)(d + col + 4) = v1; } }); }
        else epi_each8(acc, u, wr, wc, fr, fq, [&](int row, int col, f32x4 v0, f32x4 v1) {
                v4u w; w.x = cvt_pk_bf16(v0.x, v0.y); w.y = cvt_pk_bf16(v0.z, v0.w); w.z = cvt_pk_bf16(v1.x, v1.y); w.w = cvt_pk_bf16(v1.z, v1.w);
                *(v4u*)(HU + (size_t)row * DFF + (col - DFF)) = w; });
    }
};
struct EpiF32 {
    static constexpr bool PERM = false;
    float* C; int ldc;
    __device__ __forceinline__ void operator()(const f32x4 (&acc)[2][2][4][2], const pg8::Unit& u, int wr, int wc, int fr, int fq) const {
        epi_each(acc, u, wr, wc, fr, fq, [&](int row, int col, f32x4 v) { *(f32x4*)(C + (size_t)row * ldc + col) = v; });
    }
};
struct EpiPle {
    static constexpr bool PERM = false;
    float* X; bf16* XB; const float* PPF; float* yout;
    __device__ __forceinline__ void operator()(const f32x4 (&acc)[2][2][4][2], const pg8::Unit& u, int wr, int wc, int fr, int fq) const {
        epi_each(acc, u, wr, wc, fr, fq, [&](int row, int col, f32x4 v) { const size_t o = (size_t)row * D + col; const f32x4 x = *(const f32x4*)(X + o), pp = *(const f32x4*)(PPF + o);
            f32x4 r; r.x = x.x + sigmoid_f(v.x) * pp.x; r.y = x.y + sigmoid_f(v.y) * pp.y; r.z = x.z + sigmoid_f(v.z) * pp.z; r.w = x.w + sigmoid_f(v.w) * pp.w;
            *(f32x4*)(X + o) = r; *(v2u*)(XB + o) = pk4(r); if (yout) *(f32x4*)(yout + o) = r; });
    }
};
struct EpiO1 {
    static constexpr bool PERM = false;
    float* R; float* K; float* V; bf16* H1;
    __device__ __forceinline__ void operator()(const f32x4 (&acc)[2][2][4][2], const pg8::Unit& u, int wr, int wc, int fr, int fq) const {
        const int pn = u.pn;
        if (pn < 8) epi_each(acc, u, wr, wc, fr, fq, [&](int row, int col, f32x4 v) { *(f32x4*)(R + (size_t)row * D + col) = v; });
        else if (pn < 16) epi_each(acc, u, wr, wc, fr, fq, [&](int row, int col, f32x4 v) { *(f32x4*)(K + (size_t)row * D + (col - 2048)) = v; });
        else if (pn < 24) epi_each(acc, u, wr, wc, fr, fq, [&](int row, int col, f32x4 v) { *(f32x4*)(V + (size_t)row * D + (col - 4096)) = v; });
        else if (pn == 24) epi_each(acc, u, wr, wc, fr, fq, [&](int row, int col, f32x4 v) { const int lc = col - 24 * 256; if (lc < 96) { f32x4 t = (f32x4){tanh_f(v.x), tanh_f(v.y), tanh_f(v.z), tanh_f(v.w)}; *(v2u*)(H1 + (size_t)row * 512 + lc) = pk4(t); } });
        else if (pn == 25) epi_each(acc, u, wr, wc, fr, fq, [&](int row, int col, f32x4 v) { const int lc = col - 25 * 256; if (lc < 96) *(v2u*)(H1 + (size_t)row * 512 + 96 + lc) = pk4(v); });
        else if (pn == 26) epi_each(acc, u, wr, wc, fr, fq, [&](int row, int col, f32x4 v) { const int lc = col - 26 * 256; if (lc < 64) *(v2u*)(H1 + (size_t)row * 512 + 192 + lc) = pk4(v); });
        else epi_each(acc, u, wr, wc, fr, fq, [&](int row, int col, f32x4 v) { const int lc = col - 27 * 256; f32x4 t = (f32x4){sigmoid_f(v.x), sigmoid_f(v.y), sigmoid_f(v.z), sigmoid_f(v.w)}; *(v2u*)(H1 + (size_t)row * 512 + 256 + lc) = pk4(t); });
    }
};
struct EpiO2 {
    static constexpr bool PERM = false;
    float* WD; bf16* AA; bf16* VG; bf16* GG; const float* w0; const float* a0; const float* v0;
    __device__ __forceinline__ void operator()(const f32x4 (&acc)[2][2][4][2], const pg8::Unit& u, int wr, int wc, int fr, int fq) const {
        const int grp = u.pn >> 3;
        if (grp == 0) epi_each(acc, u, wr, wc, fr, fq, [&](int row, int col, f32x4 v) { const f32x4 b = *(const f32x4*)(w0 + col); f32x4 r;
            r.x = __expf(-0.6065306597126334f * sigmoid_f(b.x + v.x)); r.y = __expf(-0.6065306597126334f * sigmoid_f(b.y + v.y)); r.z = __expf(-0.6065306597126334f * sigmoid_f(b.z + v.z)); r.w = __expf(-0.6065306597126334f * sigmoid_f(b.w + v.w));
            *(f32x4*)(WD + (size_t)row * D + col) = r; });
        else if (grp == 1) epi_each(acc, u, wr, wc, fr, fq, [&](int row, int col, f32x4 v) { const int c = col - 2048; const f32x4 b = *(const f32x4*)(a0 + c);
            f32x4 r = (f32x4){sigmoid_f(b.x + v.x), sigmoid_f(b.y + v.y), sigmoid_f(b.z + v.z), sigmoid_f(b.w + v.w)}; *(v2u*)(AA + (size_t)row * D + c) = pk4(r); });
        else if (grp == 2) { if (v0) epi_each(acc, u, wr, wc, fr, fq, [&](int row, int col, f32x4 v) { const int c = col - 4096; const f32x4 b = *(const f32x4*)(v0 + c);
            f32x4 r = (f32x4){sigmoid_f(b.x + v.x), sigmoid_f(b.y + v.y), sigmoid_f(b.z + v.z), sigmoid_f(b.w + v.w)}; *(v2u*)(VG + (size_t)row * D + c) = pk4(r); }); }
        else epi_each(acc, u, wr, wc, fr, fq, [&](int row, int col, f32x4 v) { const int c = col - 6144; *(v2u*)(GG + (size_t)row * D + c) = pk4(v); });
    }
};

struct Ctx { int tid, lane, wave, gw, NGW, gtid, NT; LAS unsigned char* lds; };
__device__ __forceinline__ Ctx make_ctx(LAS unsigned char* lds) { Ctx c; int t = threadIdx.x; asm volatile("" : "+v"(t)); c.tid = t; c.lane = t & 63; c.wave = __builtin_amdgcn_readfirstlane(t >> 6); c.lds = lds;
    c.gw = blockIdx.x * NWAVES + c.wave; c.NGW = gridDim.x * NWAVES; c.gtid = blockIdx.x * NTHREADS + t; c.NT = gridDim.x * NTHREADS; return c; }

struct TJD { int src_idx; unsigned long long src_off, dst_off; int K, N, row_off; };
#define TJ_ODD(j)  {I_EWIN, (unsigned long long)(j) * 2048 * 5120, WS_WIN + (j) * SZ_WIN, 2048, 5120, 0}, {I_EWO, (unsigned long long)(j) * 2048 * 2048, WS_WOE + (j) * SZ_W22, 2048, 2048, 0}, \
    {I_CWR, (unsigned long long)(j) * 2048 * 2048, WS_W1T + (j) * SZ_W1T, 2048, 2048, 0}, {I_CWK, (unsigned long long)(j) * 2048 * 2048, WS_W1T + (j) * SZ_W1T, 2048, 2048, 2048}, {I_CWV, (unsigned long long)(j) * 2048 * 2048, WS_W1T + (j) * SZ_W1T, 2048, 2048, 4096}, \
    {I_W1, (unsigned long long)(j) * 2048 * 96, WS_W1T + (j) * SZ_W1T, 2048, 96, 6144}, {I_A1, (unsigned long long)(j) * 2048 * 96, WS_W1T + (j) * SZ_W1T, 2048, 96, 6400}, {I_G1, (unsigned long long)(j) * 2048 * 256, WS_W1T + (j) * SZ_W1T, 2048, 256, 6912}, \
    {I_CWO, (unsigned long long)(j) * 2048 * 2048, WS_WOC + (j) * SZ_W22, 2048, 2048, 0}
#define TJ_FFN(i)  {I_FWIN, (unsigned long long)(i) * 2048 * 11264, WS_FIN + (i) * SZ_FIN, 2048, 11264, 0}, {I_FWOUT, (unsigned long long)(i) * 5632 * 2048, WS_FOUT + (i) * SZ_FOUT, 5632, 2048, 0}, \
    {I_PLEG, (unsigned long long)(i) * 2048 * 2048, WS_WG + (i) * SZ_W22, 2048, 2048, 0}, {I_PLEP, (unsigned long long)(i) * 256 * 2048, WS_WP + (i) * SZ_WP, 256, 2048, 0}
__device__ const TJD tj_table[35] = { TJ_ODD(0), TJ_ODD(1), {I_V1, 0ull, WS_W1T + 1 * SZ_W1T, 2048, 64, 6656}, TJ_FFN(0), TJ_FFN(1), TJ_FFN(2), TJ_FFN(3) };
constexpr int N_TJOBS = 35;
__device__ __forceinline__ void transpose_item(const float* W, int K, int N, bf16* WT, int row_off, LAS float* scr, int item, int lane) {
    const int nblk = N / 32, kb = item / nblk, nb = item % nblk, k0 = 64 * kb, n0 = 32 * nb;
#pragma unroll 8
    for (int i = 0; i < 32; ++i) { const int kk = 2 * i + (lane >> 5); scr[kk * 33 + (lane & 31)] = W[(size_t)(k0 + kk) * N + n0 + (lane & 31)]; }
    LDS_WAIT(); asm volatile("" ::: "memory");
    const int c = lane & 7;
#pragma unroll
    for (int j = 0; j < 4; ++j) { const int n = (lane >> 3) + 8 * j; const LAS float* s = scr + (8 * c) * 33 + n;
        v4u o; o.x = cvt_pk_bf16(s[0 * 33], s[1 * 33]); o.y = cvt_pk_bf16(s[2 * 33], s[3 * 33]); o.z = cvt_pk_bf16(s[4 * 33], s[5 * 33]); o.w = cvt_pk_bf16(s[6 * 33], s[7 * 33]);
        *(v4u*)(WT + (size_t)(row_off + n0 + n) * K + k0 + 8 * c) = o; }
    LDS_WAIT(); asm volatile("" ::: "memory");
}
__device__ __forceinline__ void p0_prologue(const Args& a, const Ctx& c) {
    LAS float* scr = (LAS float*)(c.lds + c.wave * 16384);
    for (int job = 0; job < N_TJOBS; ++job) { const TJD t = tj_table[job]; const int nit = (t.K / 64) * (t.N / 32); const float* src = a.in[t.src_idx] + t.src_off; bf16* dst = (bf16*)(wsp(a) + t.dst_off);
        for (int it = c.gw; it < nit; it += c.NGW) transpose_item(src, t.K, t.N, dst, t.row_off, scr, it, c.lane); }
    const float* pw2 = inp(a, I_W2); const float* pa2 = inp(a, I_A2); const float* pv2 = inp(a, I_V2); const float* pg2 = inp(a, I_G2);
    for (int idx = c.gtid; idx < 2 * 8192 * 32; idx += c.NT) { const int j = idx / (8192 * 32), r = idx % (8192 * 32), k8 = r / 8192, n = r % 8192, k0 = k8 * 8;
        float v[8];
#pragma unroll
        for (int e = 0; e < 8; ++e) { const int k = k0 + e; float x = 0.f;
            if (n < 2048) { if (k < 96) x = pw2[((size_t)j * 96 + k) * 2048 + n]; }
            else if (n < 4096) { if (k >= 96 && k < 192) x = pa2[((size_t)j * 96 + (k - 96)) * 2048 + (n - 2048)]; }
            else if (n < 6144) { if (j == 1 && k >= 192) x = pv2[(size_t)(k - 192) * 2048 + (n - 4096)]; }
            else x = pg2[((size_t)j * 256 + k) * 2048 + (n - 6144)];
            v[e] = x; }
        v4u o; o.x = cvt_pk_bf16(v[0], v[1]); o.y = cvt_pk_bf16(v[2], v[3]); o.z = cvt_pk_bf16(v[4], v[5]); o.w = cvt_pk_bf16(v[6], v[7]);
        *(v4u*)((bf16*)(wsp(a) + WS_W2T + j * SZ_W2T) + (size_t)n * 256 + k0) = o; }
    float* X = (float*)(wsp(a) + WS_X); bf16* XB = (bf16*)(wsp(a) + WS_XB);
    const float* pxp = inp(a, I_XP); const float* pxs = inp(a, I_XS);
    for (int m = c.gw; m < M; m += c.NGW) { const float* src = m < MP ? pxp + (size_t)m * D : pxs + (size_t)(m - MP) * D;
#pragma unroll
        for (int q = 0; q < 8; ++q) { const int col = (c.lane + 64 * q) * 4; const f32x4 v = *(const f32x4*)(src + col); *(f32x4*)(X + (size_t)m * D + col) = v; *(v2u*)(XB + (size_t)m * D + col) = pk4(v); } }
    bf16* PB = (bf16*)(wsp(a) + WS_PB);
    const float* ppp = inp(a, I_PP); const float* pps = inp(a, I_PS);
    for (int idx = c.gtid; idx < 4 * M * 32; idx += c.NT) { const int i = idx / (M * 32), r = idx % (M * 32), m = r / 32, c8 = (r % 32) * 8;
        const float* src = m < MP ? ppp + ((size_t)i * MP + m) * PLE + c8 : pps + ((size_t)i * MS + (m - MP)) * PLE + c8;
        const f32x4 v0 = *(const f32x4*)src, v1 = *(const f32x4*)(src + 4);
        v4u o; o.x = cvt_pk_bf16(v0.x, v0.y); o.y = cvt_pk_bf16(v0.z, v0.w); o.z = cvt_pk_bf16(v1.x, v1.y); o.w = cvt_pk_bf16(v1.z, v1.w);
        *(v4u*)(PB + ((size_t)i * M + m) * PLE + c8) = o; }
}

__device__ __forceinline__ void ln_phase(const float* Y, const float* g, const float* b, float* X, bf16* XB, const Ctx& c) {
    for (int m = c.gw; m < M; m += c.NGW) {
        const f32x4* yr = (const f32x4*)(Y + (size_t)m * D) + c.lane; f32x4 v[8]; float s = 0.f;
#pragma unroll
        for (int q = 0; q < 8; ++q) { v[q] = yr[64 * q]; s += (v[q].x + v[q].y) + (v[q].z + v[q].w); }
        const float mean = wave_sum(s) * (1.f / D); float s2 = 0.f;
#pragma unroll
        for (int q = 0; q < 8; ++q) { v[q] = v[q] - mean; s2 += (v[q].x * v[q].x + v[q].y * v[q].y) + (v[q].z * v[q].z + v[q].w * v[q].w); }
        const float rstd = 1.f / sqrtf(wave_sum(s2) * (1.f / D) + LN_EPS);
#pragma unroll
        for (int q = 0; q < 8; ++q) { const int col = (c.lane + 64 * q) * 4; const f32x4 g4 = *(const f32x4*)(g + col), b4 = *(const f32x4*)(b + col); const f32x4 o = v[q] * rstd * g4 + b4;
            *(f32x4*)(X + (size_t)m * D + col) = o; *(v2u*)(XB + (size_t)m * D + col) = pk4(o); }
    }
}

__device__ __forceinline__ void mix_phase(const Args& a, int j, const Ctx& c) {
    const float* X = (const float*)(wsp(a) + WS_X); bf16* MIX = (bf16*)(wsp(a) + WS_MIX); const float* mu = inp(a, I_MU) + (size_t)j * 6 * D; const float* shin = inp(a, I_SHIFT);
    for (int m = c.gw; m < M; m += c.NGW) {
        const float* xr = X + (size_t)m * D; const float* xp = xr - D; bool zero_prev = false;
        if (seq_start(m)) { if (m == 0) zero_prev = true; else xp = shin + ((size_t)j * 16 + ((m - MP) >> 6)) * D; }
        float* sh = nullptr;
        if (m == MP - 1) sh = outp(a) + OFF_SHP + (size_t)j * D; else if (m >= MP && ((m - MP) & 63) == 63) sh = outp(a) + OFF_SHS + ((size_t)j * 16 + ((m - MP) >> 6)) * D;
#pragma unroll
        for (int q = 0; q < 8; ++q) { const int col = (c.lane + 64 * q) * 4; const f32x4 x = *(const f32x4*)(xr + col); f32x4 p = (f32x4){0.f, 0.f, 0.f, 0.f}; if (!zero_prev) p = *(const f32x4*)(xp + col);
            const f32x4 dx = p - x;
#pragma unroll
            for (int s = 0; s < 6; ++s) { const f32x4 mu4 = *(const f32x4*)(mu + s * D + col); *(v2u*)(MIX + ((size_t)s * M + m) * D + col) = pk4(x + dx * mu4); }
            if (sh) *(f32x4*)(sh + col) = x; }
    }
}

__device__ __forceinline__ void unpack8(v4u w, float (&f)[8]) { f[0] = bf_lo(w.x); f[1] = bf_hi(w.x); f[2] = bf_lo(w.y); f[3] = bf_hi(w.y); f[4] = bf_lo(w.z); f[5] = bf_hi(w.z); f[6] = bf_lo(w.w); f[7] = bf_hi(w.w); }
__device__ __forceinline__ void load8f(const float* p, float (&f)[8]) { const f32x4 a = *(const f32x4*)p, b = *(const f32x4*)(p + 4); f[0] = a.x; f[1] = a.y; f[2] = a.z; f[3] = a.w; f[4] = b.x; f[5] = b.y; f[6] = b.z; f[7] = b.w; }
__device__ __forceinline__ void act_phase(const Args& a, int layer, const Ctx& c) {
    const bf16* HG = (const bf16*)(wsp(a) + WS_HG); const bf16* HU = (const bf16*)(wsp(a) + WS_HU); bf16* ACT = (bf16*)(wsp(a) + WS_ACT);
    const float* cw = inp(a, I_FCW) + (size_t)layer * 3 * DFF; const float* cb = inp(a, I_FCB) + (size_t)layer * DFF; const float* cst = inp(a, I_CONV);
    constexpr int C8 = DFF / 8;
    for (int idx = c.gtid; idx < M * C8; idx += c.NT) { const int row = idx / C8, col = (idx % C8) * 8;
        const int t = row < MP ? row : ((row - MP) & 63); const float* cprev = row < MP ? nullptr : cst + (((size_t)layer * 16 + ((row - MP) >> 6)) * 2) * DFF;
        float h2[8], h1[8], h0[8], hu[8], w0[8], w1[8], w2[8], bb[8];
        unpack8(*(const v4u*)(HG + (size_t)row * DFF + col), h2); unpack8(*(const v4u*)(HU + (size_t)row * DFF + col), hu);
        if (t >= 1) unpack8(*(const v4u*)(HG + (size_t)(row - 1) * DFF + col), h1);
        else if (cprev) load8f(cprev + DFF + col, h1);
        else {
#pragma unroll
            for (int e = 0; e < 8; ++e) h1[e] = 0.f; }
        if (t >= 2) unpack8(*(const v4u*)(HG + (size_t)(row - 2) * DFF + col), h0);
        else if (cprev) load8f(cprev + (t == 1 ? DFF : 0) + col, h0);
        else {
#pragma unroll
            for (int e = 0; e < 8; ++e) h0[e] = 0.f; }
        load8f(cw + col, w0); load8f(cw + DFF + col, w1); load8f(cw + 2 * DFF + col, w2); load8f(cb + col, bb);
        float o[8];
#pragma unroll
        for (int e = 0; e < 8; ++e) { const float hc = bb[e] + h0[e] * w0[e] + h1[e] * w1[e] + h2[e] * w2[e]; o[e] = gelu_f(hc) * hu[e]; }
        v4u w; w.x = cvt_pk_bf16(o[0], o[1]); w.y = cvt_pk_bf16(o[2], o[3]); w.z = cvt_pk_bf16(o[4], o[5]); w.w = cvt_pk_bf16(o[6], o[7]);
        *(v4u*)(ACT + (size_t)row * DFF + col) = w; }
}

__device__ __forceinline__ void spatial_task(const Args& a, int j, int row0, int n, int h, const Ctx& c) {
    LAS float* vn = (LAS float*)c.lds;
    LAS float* Wl = vn + 128 * 128;
    LAS float* st = Wl + 128 * 132;
    const bf16* ZV = (const bf16*)(wsp(a) + WS_ZV); const bf16* U = (const bf16*)(wsp(a) + WS_U); bf16* AO = (bf16*)(wsp(a) + WS_AO);
    const float* lg = inp(a, I_LNVG) + (size_t)j * AW; const float* lb = inp(a, I_LNVB) + (size_t)j * AW;
    const float* Wg = inp(a, I_EWS) + ((size_t)j * 8 + h) * 128 * 128; const float* bs = inp(a, I_EBS) + ((size_t)j * 8 + h) * 128;
    for (int rr = 0; rr < 16; ++rr) { const int r = c.wave * 16 + rr; if (r < n) {
        const v4u* zr = (const v4u*)(ZV + (size_t)(row0 + r) * AW) + c.lane * 2; float f[16]; { float t8[8]; unpack8(zr[0], t8);
#pragma unroll
            for (int e = 0; e < 8; ++e) f[e] = t8[e]; unpack8(zr[1], t8);
#pragma unroll
            for (int e = 0; e < 8; ++e) f[8 + e] = t8[e]; }
        float s = 0.f;
#pragma unroll
        for (int e = 0; e < 16; ++e) s += f[e];
        const float mean = wave_sum(s) * (1.f / AW); float s2 = 0.f;
#pragma unroll
        for (int e = 0; e < 16; ++e) { const float d = f[e] - mean; s2 += d * d; }
        const float rstd = 1.f / sqrtf(wave_sum(s2) * (1.f / AW) + LN_EPS);
        if (c.lane == 0) { st[r * 2] = mean; st[r * 2 + 1] = rstd; } } }
    for (int k = 0; k < 32; ++k) { const int idx = c.tid + k * NTHREADS, t = idx >> 7, s = idx & 127; Wl[t * 132 + s] = Wg[idx]; }
    __syncthreads();
    float* vaout = (row0 >= MP) ? outp(a) + OFF_VAS + (size_t)j * MS * AW + (size_t)(row0 - MP) * AW + h * 128 : nullptr;
    for (int k = 0; k < 32; ++k) { const int idx = c.tid + k * NTHREADS, s = idx >> 7, cc = idx & 127;
        if (s < n) { const float z = __uint_as_float((unsigned)ZV[(size_t)(row0 + s) * AW + h * 128 + cc] << 16);
            const float v = (z - st[s * 2]) * st[s * 2 + 1] * lg[h * 128 + cc] + lb[h * 128 + cc]; vn[s * 128 + cc] = v; if (vaout) vaout[(size_t)s * AW + cc] = v; } }
    __syncthreads();
    const int t = c.tid >> 2, cq = c.tid & 3;
    if (t < n) { const int s_end = (t < 64) ? 64 : n;
        f32x4 acc[8];
#pragma unroll
        for (int e = 0; e < 8; ++e) acc[e] = (f32x4){0.f, 0.f, 0.f, 0.f};
        for (int s = 0; s < s_end; s += 4) { const f32x4 w4 = *(const LAS f32x4*)(Wl + t * 132 + s);
#pragma unroll
            for (int q = 0; q < 4; ++q) { const float w = w4[q]; const LAS f32x4* vr = (const LAS f32x4*)(vn + (s + q) * 128 + cq * 32);
#pragma unroll
                for (int e = 0; e < 8; ++e) acc[e] += vr[e] * w; } }
        const float bias = bs[t]; const size_t row = (size_t)(row0 + t);
        const v4u* up = (const v4u*)(U + row * AW + h * 128 + cq * 32); v4u* op = (v4u*)(AO + row * D + h * 128 + cq * 32);
#pragma unroll
        for (int e2 = 0; e2 < 4; ++e2) { float uf[8]; unpack8(up[e2], uf); const f32x4 a0 = acc[2 * e2] + bias, a1 = acc[2 * e2 + 1] + bias;
            v4u w; w.x = cvt_pk_bf16(uf[0] * a0.x, uf[1] * a0.y); w.y = cvt_pk_bf16(uf[2] * a0.z, uf[3] * a0.w); w.z = cvt_pk_bf16(uf[4] * a1.x, uf[5] * a1.y); w.w = cvt_pk_bf16(uf[6] * a1.z, uf[7] * a1.w); op[e2] = w; } }
    __syncthreads();
}

__device__ __forceinline__ void attn_wave_task(const Args& a, int j, int task, const Ctx& c) {
    LAS float* kl = (LAS float*)(c.lds + c.wave * 8192);
    LAS float* vl = kl + 1024;
    const float* QF = (const float*)(wsp(a) + WS_QF); bf16* AO = (bf16*)(wsp(a) + WS_AO);
    int h, row0, pos0, b = 0; const bool smp = task >= 2048;
    if (!smp) { h = task & 15; const int qb = task >> 4; row0 = qb * 64; pos0 = row0; } else { const int s = task - 2048; h = s & 15; b = s >> 4; row0 = MP + b * 64; pos0 = 2048; }
    const int ipos = pos0 + c.lane;
    float q[64], o[64];
    { const f32x4* qp = (const f32x4*)(QF + (size_t)(row0 + c.lane) * 1024 + h * 64);
#pragma unroll
      for (int d4 = 0; d4 < 16; ++d4) { const f32x4 v = qp[d4]; q[4 * d4] = v.x * 0.125f; q[4 * d4 + 1] = v.y * 0.125f; q[4 * d4 + 2] = v.z * 0.125f; q[4 * d4 + 3] = v.w * 0.125f; } }
#pragma unroll
    for (int d = 0; d < 64; ++d) o[d] = 0.f;
    float R = 0.f;
    const float* kp_new = smp ? outp(a) + OFF_KS + (size_t)j * MS * 1024 + (size_t)(b * 64) * 1024 + h * 64 : outp(a) + OFF_KP + (size_t)j * MP * 1024 + h * 64;
    const float* vp_new = smp ? outp(a) + OFF_VS + (size_t)j * MS * 1024 + (size_t)(b * 64) * 1024 + h * 64 : outp(a) + OFF_VP + (size_t)j * MP * 1024 + h * 64;
    const float* kp_old = inp(a, I_CK) + ((size_t)j * 16 + b) * 2048 * 1024 + h * 64; const float* vp_old = inp(a, I_CV) + ((size_t)j * 16 + b) * 2048 * 1024 + h * 64;
    for (int jt = (pos0 + 64) / 16 - 1; jt >= 0; --jt) {
        const int kpos0 = jt * 16;
        const float* ksrc; const float* vsrc;
        if (smp && kpos0 < 2048) { ksrc = kp_old + (size_t)kpos0 * 1024; vsrc = vp_old + (size_t)kpos0 * 1024; }
        else { const int r = kpos0 - (smp ? 2048 : 0); ksrc = kp_new + (size_t)r * 1024; vsrc = vp_new + (size_t)r * 1024; }
#pragma unroll
        for (int k = 0; k < 4; ++k) { const int e = c.lane + 64 * k, key = e >> 4, d4 = e & 15;
            *(LAS f32x4*)(kl + key * 64 + d4 * 4) = *(const f32x4*)(ksrc + (size_t)key * 1024 + d4 * 4);
            *(LAS f32x4*)(vl + key * 64 + d4 * 4) = *(const f32x4*)(vsrc + (size_t)key * 1024 + d4 * 4); }
        LDS_WAIT(); asm volatile("" ::: "memory");
#pragma unroll 1
        for (int kk = 15; kk >= 0; --kk) {
            const LAS f32x4* kr = (const LAS f32x4*)(kl + kk * 64); float z0 = 0.f, z1 = 0.f, z2 = 0.f, z3 = 0.f;
#pragma unroll
            for (int hf = 0; hf < 2; ++hf) {
#pragma unroll
                for (int d4 = 8 * hf; d4 < 8 * hf + 8; ++d4) { const f32x4 kv = kr[d4]; z0 += q[4 * d4] * kv.x; z1 += q[4 * d4 + 1] * kv.y; z2 += q[4 * d4 + 2] * kv.z; z3 += q[4 * d4 + 3] * kv.w; }
                asm volatile("" ::: "memory"); }
            const float z = (z0 + z1) + (z2 + z3);
            const bool valid = (kpos0 + kk) < ipos;
            const float sp = fmaxf(z, 0.f) + __logf(1.f + __expf(-fabsf(z)));
            const float wgt = valid ? __expf(z - sp + R) : 0.f;
            R += valid ? -sp : 0.f;
            const LAS f32x4* vr = (const LAS f32x4*)(vl + kk * 64);
#pragma unroll
            for (int hf = 0; hf < 2; ++hf) {
#pragma unroll
                for (int d4 = 8 * hf; d4 < 8 * hf + 8; ++d4) { const f32x4 vv = vr[d4]; o[4 * d4] += wgt * vv.x; o[4 * d4 + 1] += wgt * vv.y; o[4 * d4 + 2] += wgt * vv.z; o[4 * d4 + 3] += wgt * vv.w; }
                asm volatile("" ::: "memory"); }
        }
        LDS_WAIT(); asm volatile("" ::: "memory");
        if (__all(R < -SB_THRESH)) break;
    }
    v4u* op = (v4u*)(AO + (size_t)(row0 + c.lane) * D + 1024 + h * 64);
#pragma unroll
    for (int d8 = 0; d8 < 8; ++d8) { v4u w; w.x = cvt_pk_bf16(o[8 * d8], o[8 * d8 + 1]); w.y = cvt_pk_bf16(o[8 * d8 + 2], o[8 * d8 + 3]); w.z = cvt_pk_bf16(o[8 * d8 + 4], o[8 * d8 + 5]); w.w = cvt_pk_bf16(o[8 * d8 + 6], o[8 * d8 + 7]); op[d8] = w; }
}
__device__ __forceinline__ void even_mix_phase(const Args& a, int j, const Ctx& c) {
    for (int task = blockIdx.x; task < 928; task += gridDim.x) {
        if (task < 512) spatial_task(a, j, (task >> 3) * 128, 128, task & 7, c);
        else if (task < 640) spatial_task(a, j, MP + ((task - 512) >> 3) * 64, 64, task & 7, c);
        else attn_wave_task(a, j, (task - 640) * 8 + c.wave, c);
    }
}

constexpr int SC_T = 32;
constexpr int SC_BUF = (5 * SC_T * 64 + 2 * SC_T * 16) * 4;
__device__ __forceinline__ void scan_load_chunk(const Args& a, int j, bool first, int row_base, int h, int rg, LAS float* buf, int lt) {
    const int s = lt >> 3, sub = lt & 7, c0 = sub * 8; const size_t off = (size_t)(row_base + s) * D + h * 64 + c0; const int ch = h * 64 + c0;
    float r[8], k[8], v[8], w[8], aa[8], kkp[8], kap[8];
    load8f((const float*)(wsp(a) + WS_R) + off, r); load8f((const float*)(wsp(a) + WS_K) + off, k); load8f((const float*)(wsp(a) + (first ? WS_V1 : WS_V3)) + off, v); load8f((const float*)(wsp(a) + WS_WD) + off, w);
    unpack8(*(const v4u*)((const bf16*)(wsp(a) + WS_AA) + off), aa);
    load8f(inp(a, I_KK) + (size_t)j * D + ch, kkp); load8f(inp(a, I_KA) + (size_t)j * D + ch, kap);
    if (!first) { float vf[8], vg[8]; load8f((const float*)(wsp(a) + WS_V1) + off, vf); unpack8(*(const v4u*)((const bf16*)(wsp(a) + WS_VG) + off), vg);
#pragma unroll
        for (int e = 0; e < 8; ++e) v[e] = v[e] + (vf[e] - v[e]) * vg[e]; }
    float kk[8], ss = 0.f;
#pragma unroll
    for (int e = 0; e < 8; ++e) { kk[e] = k[e] * kkp[e]; ss += kk[e] * kk[e]; }
    ss = reduce8(ss);
    const float inv = 1.f / fmaxf(sqrtf(ss), 1e-12f);
    LAS float* pr = buf + s * 64 + c0; LAS float* pw = pr + SC_T * 64; LAS float* pk = pw + SC_T * 64; LAS float* pa = pk + SC_T * 64; LAS float* pb = pa + SC_T * 64;
#pragma unroll
    for (int e = 0; e < 8; ++e) { const float kn = kk[e] * inv; pr[e] = r[e]; pw[e] = w[e]; pk[e] = k[e] * (1.f + (aa[e] - 1.f) * kap[e]); pa[e] = -kn; pb[e] = kn * aa[e]; }
    if ((sub >> 1) == rg) { LAS float* pv = buf + 5 * SC_T * 64 + s * 16 + (sub & 1) * 8;
#pragma unroll
        for (int e = 0; e < 8; ++e) pv[e] = v[e]; }
}
__device__ __forceinline__ void scan_store_y(const Args& a, int row_base, int h, int rg, const LAS float* buf, int lt) {
    const LAS float* yb = buf + 5 * SC_T * 64 + SC_T * 16; float* YS = (float*)(wsp(a) + WS_YS);
#pragma unroll
    for (int k = 0; k < 2; ++k) { const int idx = lt + 256 * k, s = idx >> 4, i = idx & 15; YS[(size_t)(row_base + s) * D + h * 64 + rg * 16 + i] = yb[s * 16 + i]; }
}
__device__ __forceinline__ void scan_phase(const Args& a, int j, const Ctx& c) {
    const bool first = (j == 0); const int G = gridDim.x, bid = blockIdx.x;
    constexpr int NPT = 128, NST = 2048;
    for (int it = 0;; ++it) {
        int task;
        if (G > NPT) { if (bid < NPT) { if (it > 0) break; task = bid; } else { task = NPT + (bid - NPT) + it * (G - NPT); if (task >= NPT + NST) break; } }
        else { task = bid + it * G; if (task >= NPT + NST) break; }
        int h, rg, row0, T; const float* s0 = nullptr; float* sout;
        if (task < NPT) { h = task >> 2; rg = task & 3; row0 = 0; T = MP; sout = outp(a) + OFF_WKVP + ((size_t)j * 32 + h) * 4096; }
        else { const int s = task - NPT, b = s >> 7; h = (s >> 2) & 31; rg = s & 3; row0 = MP + b * 64; T = 64; const size_t so = (((size_t)j * 16 + b) * 32 + h) * 4096; s0 = inp(a, I_WKV) + so; sout = outp(a) + OFF_WKVS + so; }
        const int nch = T / SC_T;
        LAS float* buf0 = (LAS float*)c.lds; LAS float* buf1 = (LAS float*)(c.lds + SC_BUF);
        const int jq = c.lane & 15, il = c.wave * 4 + (c.lane >> 4);
        f32x4 S = (f32x4){0.f, 0.f, 0.f, 0.f};
        if (c.wave < 4) { if (s0) S = *(const f32x4*)(s0 + (size_t)(rg * 16 + il) * 64 + 4 * jq); }
        else scan_load_chunk(a, j, first, row0, h, rg, buf0, c.tid - 256);
        __syncthreads();
        for (int ch = 0; ch < nch; ++ch) {
            LAS float* cur = (ch & 1) ? buf1 : buf0; LAS float* oth = (ch & 1) ? buf0 : buf1;
            if (c.wave < 4) {
                const LAS float* pr = cur + 4 * jq; LAS float* yb = cur + 5 * SC_T * 64 + SC_T * 16; const LAS float* pv = cur + 5 * SC_T * 64 + il;
#pragma unroll 4
                for (int t = 0; t < SC_T; ++t) {
                    const f32x4 r4 = *(const LAS f32x4*)(pr + t * 64), w4 = *(const LAS f32x4*)(pr + (SC_T + t) * 64), k4 = *(const LAS f32x4*)(pr + (2 * SC_T + t) * 64),
                                a4 = *(const LAS f32x4*)(pr + (3 * SC_T + t) * 64), b4 = *(const LAS f32x4*)(pr + (4 * SC_T + t) * 64);
                    const float vv = pv[t * 16];
                    const float sa = reduce16((S.x * a4.x + S.y * a4.y) + (S.z * a4.z + S.w * a4.w));
                    S = S * w4 + k4 * vv + b4 * sa;
                    const float y = reduce16((S.x * r4.x + S.y * r4.y) + (S.z * r4.z + S.w * r4.w));
                    if (jq == 0) yb[t * 16 + il] = y;
                }
            } else {
                const int lt = c.tid - 256;
                if (ch > 0) scan_store_y(a, row0 + (ch - 1) * SC_T, h, rg, oth, lt);
                if (ch + 1 < nch) { LDS_WAIT(); scan_load_chunk(a, j, first, row0 + (ch + 1) * SC_T, h, rg, oth, lt); }
            }
            __syncthreads();
        }
        if (c.wave >= 4) scan_store_y(a, row0 + (nch - 1) * SC_T, h, rg, ((nch - 1) & 1) ? buf1 : buf0, c.tid - 256);
        else *(f32x4*)(sout + (size_t)(rg * 16 + il) * 64 + 4 * jq) = S;
        __syncthreads();
    }
}

__device__ __forceinline__ void post_phase(const Args& a, int j, const Ctx& c) {
    const bool first = (j == 0);
    const float* YS = (const float*)(wsp(a) + WS_YS); const float* R = (const float*)(wsp(a) + WS_R); const float* K = (const float*)(wsp(a) + WS_K); const float* V = (const float*)(wsp(a) + (first ? WS_V1 : WS_V3));
    const float* VF = (const float*)(wsp(a) + WS_V1); const bf16* AA = (const bf16*)(wsp(a) + WS_AA); const bf16* VG = (const bf16*)(wsp(a) + WS_VG); const bf16* GG = (const bf16*)(wsp(a) + WS_GG); bf16* YG = (bf16*)(wsp(a) + WS_YG);
    const float* kap = inp(a, I_KA) + (size_t)j * D; const float* rkp = inp(a, I_RK) + (size_t)j * D; const float* gng = inp(a, I_GNG) + (size_t)j * D; const float* gnb = inp(a, I_GNB) + (size_t)j * D;
    const int g = c.lane >> 4, l16 = c.lane & 15;
    for (int wi = c.gw; wi < M * 32 / 4; wi += c.NGW) { const int item = wi * 4 + g, row = item >> 5, h = item & 31, ch = h * 64 + l16 * 4; const size_t off = (size_t)row * D + ch;
        const f32x4 y = *(const f32x4*)(YS + off), r = *(const f32x4*)(R + off), k = *(const f32x4*)(K + off); f32x4 v = *(const f32x4*)(V + off);
        const v2u aw = *(const v2u*)(AA + off), gw2 = *(const v2u*)(GG + off);
        const f32x4 aa = (f32x4){bf_lo(aw.x), bf_hi(aw.x), bf_lo(aw.y), bf_hi(aw.y)}, gg = (f32x4){bf_lo(gw2.x), bf_hi(gw2.x), bf_lo(gw2.y), bf_hi(gw2.y)};
        if (!first) { const f32x4 vf = *(const f32x4*)(VF + off); const v2u vw = *(const v2u*)(VG + off); const f32x4 vg = (f32x4){bf_lo(vw.x), bf_hi(vw.x), bf_lo(vw.y), bf_hi(vw.y)}; v = v + (vf - v) * vg; }
        const f32x4 ka4 = *(const f32x4*)(kap + ch), rk4 = *(const f32x4*)(rkp + ch), g4 = *(const f32x4*)(gng + ch), b4 = *(const f32x4*)(gnb + ch);
        const f32x4 k2 = k * ((aa - 1.f) * ka4 + 1.f);
        const float mean = reduce16((y.x + y.y) + (y.z + y.w)) * (1.f / 64.f); const f32x4 dy = y - mean;
        const float var = reduce16((dy.x * dy.x + dy.y * dy.y) + (dy.z * dy.z + dy.w * dy.w)) * (1.f / 64.f);
        const float rstd = 1.f / sqrtf(var + GN_EPS);
        const f32x4 rk = r * k2 * rk4; const float bonus = reduce16((rk.x + rk.y) + (rk.z + rk.w));
        const f32x4 o = (dy * rstd * g4 + b4 + v * bonus) * gg;
        *(v2u*)(YG + off) = pk4(o); }
}

constexpr int N_PHASES = 1 + 12 * 4;
__host__ __device__ constexpr bool phase_exists(int ph) { return ph == 0 || (ph < N_PHASES && !((((ph - 1) / 12) & 1) == 0 && ((ph - 1) % 12) >= 2 && ((ph - 1) % 12) <= 4)); }

__global__ void __launch_bounds__(NTHREADS, 2) fwd_kernel(Args args) {
    extern __shared__ __attribute__((aligned(16))) unsigned char lds_raw[];
    LAS unsigned char* lds = (LAS unsigned char*)lds_raw;
    const int G = gridDim.x;
    const int lo = args.ph_lo, hi = args.ph_hi; const bool fused = (hi - lo) > 1;
    if (threadIdx.x < 64) ((LAS unsigned*)(lds + LDSCTL_OFF))[threadIdx.x] = 0u;
    __syncthreads();
    XcdBarrier bar; bar.bar = (unsigned*)(wsp(args) + WS_CTL) + CW_BAR; bar.x = 0; bar.st = nullptr;
    if (fused) bar = xcd_barrier_post((unsigned*)(wsp(args) + WS_CTL) + CW_BAR, (volatile LAS unsigned*)(lds + LDSCTL_OFF));
#ifndef PHMASK
#define PHMASK 0xFFFFu
#endif
#define SEL(b) (((PHMASK) >> (b)) & 1u)
#define IN(k) (lo <= (k) && (k) < hi)
#define SEAM() do { if (fused) xcd_barrier(bar); } while (0)

    if (SEL(0) && IN(0)) { const Ctx c = make_ctx(lds); p0_prologue(args, c); SEAM(); }

    for (int L = 0; L < 4; ++L) {
        const int base = 1 + 12 * L, j = L >> 1;
#define ws wsp(args)
#define X ((float*)(wsp(args) + WS_X))
#define XB ((bf16*)(wsp(args) + WS_XB + (size_t)(L & 1) * SZ_X16))
#define XBN ((bf16*)(wsp(args) + WS_XB + (size_t)((L + 1) & 1) * SZ_X16))
#define Y ((float*)(wsp(args) + WS_Y))
        if ((L & 1) == 0) {
            if (SEL(1) && IN(base + 0)) {
                pg8::Gemm g{XB, (const bf16*)(ws + WS_WIN + j * SZ_WIN), M, EVEN_IN, D, D, 0ull, 0ull, 0};
                pg8::StaticOrder S; S.init(M, EVEN_IN, G, (int)blockIdx.x);
                EpiEvenIn E{(bf16*)(ws + WS_U), (bf16*)(ws + WS_ZV), (float*)(ws + WS_QF), outp(args), j};
                pg8::gemm_phase<EpiEvenIn, pg8::StaticOrder, true>(lds, g, S, E);
                SEAM();
            }
            if (SEL(2) && IN(base + 1)) { const Ctx c = make_ctx(lds); even_mix_phase(args, j, c); SEAM(); }
            if (SEL(3) && IN(base + 5)) {
                pg8::Gemm g{(const bf16*)(ws + WS_AO), (const bf16*)(ws + WS_WOE + j * SZ_W22), M, D, D, D, 0ull, 0ull, 0};
                pg8::StaticOrder S; S.init(M, D, G, (int)blockIdx.x);
                EpiResid E{X, Y};
                pg8::gemm_phase<EpiResid, pg8::StaticOrder, true>(lds, g, S, E);
                SEAM();
            }
        } else {
            if (SEL(4) && IN(base + 0)) { const Ctx c = make_ctx(lds); mix_phase(args, j, c); SEAM(); }
            if (SEL(5) && IN(base + 1)) {
                pg8::Gemm g{(const bf16*)(ws + WS_MIX), (const bf16*)(ws + WS_W1T + j * SZ_W1T), M, N_O1, D, D, 0x2222222200000000ull, 0x0000534133333333ull, (size_t)M * D};
                pg8::StaticOrder S; S.init(M, N_O1, G, (int)blockIdx.x);
                EpiO1 E{(float*)(ws + WS_R), (float*)(ws + WS_K), (float*)(ws + (j == 0 ? WS_V1 : WS_V3)), (bf16*)(ws + WS_H1)};
                pg8::gemm_phase<EpiO1, pg8::StaticOrder, true>(lds, g, S, E);
                SEAM();
            }
            if (SEL(6) && IN(base + 2)) {
                pg8::Gemm g{(const bf16*)(ws + WS_H1), (const bf16*)(ws + WS_W2T + j * SZ_W2T), M, N_O2, 256, 512, 0ull, 0x1111111100000000ull, 256};
                pg8::StaticOrder S; S.init(M, N_O2, G, (int)blockIdx.x);
                EpiO2 E{(float*)(ws + WS_WD), (bf16*)(ws + WS_AA), (bf16*)(ws + WS_VG), (bf16*)(ws + WS_GG), inp(args, I_W0) + (size_t)j * D, inp(args, I_A0) + (size_t)j * D, j == 0 ? nullptr : inp(args, I_V0)};
                pg8::gemm_phase<EpiO2, pg8::StaticOrder, true>(lds, g, S, E);
                SEAM();
            }
            if (SEL(7) && IN(base + 3)) { const Ctx c = make_ctx(lds); scan_phase(args, j, c); SEAM(); }
            if (SEL(8) && IN(base + 4)) { const Ctx c = make_ctx(lds); post_phase(args, j, c); SEAM(); }
            if (SEL(9) && IN(base + 5)) {
                pg8::Gemm g{(const bf16*)(ws + WS_YG), (const bf16*)(ws + WS_WOC + j * SZ_W22), M, D, D, D, 0ull, 0ull, 0};
                pg8::StaticOrder S; S.init(M, D, G, (int)blockIdx.x);
                EpiResid E{X, Y};
                pg8::gemm_phase<EpiResid, pg8::StaticOrder, true>(lds, g, S, E);
                SEAM();
            }
        }
        if (SEL(10) && IN(base + 6)) { const Ctx c = make_ctx(lds); ln_phase(Y, inp(args, I_LN1G) + (size_t)L * D, inp(args, I_LN1B) + (size_t)L * D, X, XB, c); SEAM(); }
        if (SEL(11) && IN(base + 7)) {
            pg8::Gemm g{XB, (const bf16*)(ws + WS_FIN + L * SZ_FIN), M, 2 * DFF, D, D, 0ull, 0ull, 0};
            pg8::StaticOrder S; S.init(M, 2 * DFF, G, (int)blockIdx.x);
            EpiFfnIn E{(bf16*)(ws + WS_HG), (bf16*)(ws + WS_HU), outp(args), L};
            pg8::gemm_phase<EpiFfnIn, pg8::StaticOrder, true>(lds, g, S, E);
            SEAM();
        }
        if (SEL(12) && IN(base + 8)) {
            { const Ctx c = make_ctx(lds); act_phase(args, L, c); }
            __syncthreads();
            pg8::Gemm g{(const bf16*)(ws + WS_PB + L * SZ_PB), (const bf16*)(ws + WS_WP + L * SZ_WP), M, D, PLE, PLE, 0ull, 0ull, 0};
            pg8::StaticOrder S; S.init(M, D, G, (int)blockIdx.x);
            EpiF32 E{(float*)(ws + WS_PPF), D};
            pg8::gemm_phase<EpiF32, pg8::StaticOrder, true>(lds, g, S, E);
            SEAM();
        }
        if (SEL(13) && IN(base + 9)) {
            pg8::Gemm g{(const bf16*)(ws + WS_ACT), (const bf16*)(ws + WS_FOUT + L * SZ_FOUT), M, D, DFF, DFF, 0ull, 0ull, 0};
            pg8::StaticOrder S; S.init(M, D, G, (int)blockIdx.x);
            EpiResid E{X, Y};
            pg8::gemm_phase<EpiResid, pg8::StaticOrder, true>(lds, g, S, E);
            SEAM();
        }
        if (SEL(14) && IN(base + 10)) { const Ctx c = make_ctx(lds); ln_phase(Y, inp(args, I_LN2G) + (size_t)L * D, inp(args, I_LN2B) + (size_t)L * D, X, XB, c); SEAM(); }
        if (SEL(15) && IN(base + 11)) {
            pg8::Gemm g{XB, (const bf16*)(ws + WS_WG + L * SZ_W22), M, D, D, D, 0ull, 0ull, 0};
            pg8::StaticOrder S; S.init(M, D, G, (int)blockIdx.x);
            EpiPle E{X, XBN, (const float*)(ws + WS_PPF), L == 3 ? outp(args) : nullptr};
            pg8::gemm_phase<EpiPle, pg8::StaticOrder, true>(lds, g, S, E);
            SEAM();
        }
    }
#undef IN
#undef SEAM
#undef ws
#undef X
#undef XB
#undef XBN
#undef Y
}

extern "C" void kernel_launch(void* const* d_in, const int* in_sizes, int n_in, void* d_out, int out_size, void* d_ws, size_t ws_size, hipStream_t stream) {
    static int grid = 0;
    if (grid == 0) {
        if (n_in != N_IN || out_size != (int)OUT_END || ws_size < WS_END) { fprintf(stderr, "kernel_launch: unexpected problem shape (n_in %d, out %d, ws %zu; need %d, %zu, %zu)\n", n_in, out_size, ws_size, (int)N_IN, (size_t)OUT_END, (size_t)WS_END); grid = -1; return; }
        int dev = 0, cus = 0, per_cu = 0;
        if (hipGetDevice(&dev) != hipSuccess || hipDeviceGetAttribute(&cus, hipDeviceAttributeMultiprocessorCount, dev) != hipSuccess) { grid = -1; return; }
        if (hipFuncSetAttribute((const void*)fwd_kernel, hipFuncAttributeMaxDynamicSharedMemorySize, LDS_BYTES) != hipSuccess) { fprintf(stderr, "kernel_launch: hipFuncSetAttribute failed\n"); grid = -1; return; }
        if (hipOccupancyMaxActiveBlocksPerMultiprocessor(&per_cu, (const void*)fwd_kernel, NTHREADS, LDS_BYTES) != hipSuccess || per_cu < 1) fprintf(stderr, "kernel_launch: occupancy query reports %d\n", per_cu);
        (void)hipGetLastError();
        grid = cus;
    }
    if (grid < 0) return;
    (void)in_sizes;
    if (hipMemsetAsync((char*)d_ws + WS_CTL, 0, CTL_ZERO_BYTES, stream) != hipSuccess) return;
    Args a{};
    for (int i = 0; i < N_IN; ++i) a.in[i] = (const float*)d_in[i];
    a.out = (float*)d_out; a.ws = (unsigned char*)d_ws;
#if MK_ONE_LAUNCH
    a.ph_lo = 0; a.ph_hi = N_PHASES;
    hipLaunchKernelGGL(fwd_kernel, dim3(grid), dim3(NTHREADS), LDS_BYTES, stream, a);
#else
    for (int ph = 0; ph < N_PHASES; ++ph) { if (!phase_exists(ph)) continue; a.ph_lo = ph; a.ph_hi = ph + 1;
        hipLaunchKernelGGL(fwd_kernel, dim3(grid), dim3(NTHREADS), LDS_BYTES, stream, a); }
#endif
}
```

```cpp
#include <hip/hip_runtime.h>
#include <cstdio>
#include <cstdint>

#ifndef MK_ONE_LAUNCH
#define MK_ONE_LAUNCH 1
#endif

namespace pg8 {
#define PG8_LAS __attribute__((address_space(3)))
typedef unsigned short bf16_t;
typedef short bf16x8 __attribute__((ext_vector_type(8)));
typedef float f32x4 __attribute__((ext_vector_type(4)));
typedef unsigned u32x4 __attribute__((ext_vector_type(4)));
typedef unsigned u32x2 __attribute__((ext_vector_type(2)));
constexpr int BM = 256, BK = 64, HALF = 128, HTB = HALF * BK * 2  , STAGE_BYTES = 8 * HTB, NXCD = 8, WGM = 8;

__host__ __device__ __forceinline__ int lds_byte(int r, int c) { const int st = (r >> 4) * 2 + (c >> 5), rr = r & 15, cc = c & 31, ob = rr * 64 + cc * 2; return st * 1024 + (ob ^ (((ob >> 9) & 1) << 5)); }
__host__ __device__ __forceinline__ void stage_rc(int b, int& R, int& C) { const int st = b / 1024, sb = b % 1024, swz = sb ^ (((sb >> 9) & 1) << 5); R = (st >> 1) * 16 + swz / 64; C = (st & 1) * 32 + (swz % 64) / 2; }
__host__ __device__ __forceinline__ int perm32(int rho) { const int n = rho >> 4, i = rho & 15; return 8 * (i >> 2) + 4 * n + (i & 3); }

struct Unit { int pm, pn; };
struct Gemm { const bf16_t* A; const bf16_t* Bt; int M, N, K, lda; unsigned long long asel0, asel1; size_t asel_stride; };
__device__ __forceinline__ const char* a_base(const Gemm& g, const Unit& u) {
    size_t off = 0;
    if (g.asel_stride) { const unsigned sel = (unsigned)(((u.pn < 16) ? (g.asel0 >> (4 * u.pn)) : (g.asel1 >> (4 * (u.pn & 15)))) & 15ull); off = (size_t)sel * g.asel_stride; }
    return (const char*)(g.A + off) + (size_t)u.pm * ((size_t)BM * g.lda * 2);
}

struct StaticOrder {
    int nM, nN, nwg, G, c;
    __host__ __device__ void init(int M, int N, int G_, int c_) { nM = M / BM; nN = N / BM; nwg = nM * nN; G = G_; c = c_; }
    __host__ __device__ bool next(int i, Unit& u) const {
        const long L = (long)i * G + c; if (L >= nwg) return false;
        int wgid = (int)L; { const int q = nwg / NXCD, r = nwg % NXCD, xcd = wgid % NXCD, off = wgid / NXCD; wgid = (xcd < r ? xcd * (q + 1) : r * (q + 1) + (xcd - r) * q) + off; }
        const int nig = WGM * nN, gid = wgid / nig, fm = gid * WGM, gsz = (nM - fm) < WGM ? (nM - fm) : WGM;
        u.pm = fm + ((wgid % nig) % gsz); u.pn = (wgid % nig) / gsz; return true;
    }
    __device__ __forceinline__ void a_ready(const Unit&) const {}
    __device__ __forceinline__ void done(const Unit&) const {}
};

__device__ __forceinline__ unsigned cvt_pk_bf16(float lo, float hi) { unsigned r; asm volatile("v_cvt_pk_bf16_f32 %0, %1, %2" : "=v"(r) : "v"(lo), "v"(hi)); return r; }

template <class Epi, class Sched, bool ALIGN_EPI = false>
__device__ __forceinline__ void gemm_phase(PG8_LAS unsigned char* lds, const Gemm g, const Sched& S, const Epi& E) {
    int tid_ = threadIdx.x; asm volatile("" : "+v"(tid_));
    const int tid = tid_, wid = __builtin_amdgcn_readfirstlane(tid >> 6), lane = tid & 63, wr = wid >> 2, wc = wid & 3, fr = lane & 15, fq = lane >> 4;
    const int K = g.K, nt = K / BK, lda = g.lda;
    unsigned voffA[2], voffB[2];
#pragma unroll
    for (int i = 0; i < 2; ++i) { int R, C; stage_rc(tid * 16 + i * 8192, R, C); const int Rb = Epi::PERM ? ((R & ~31) + perm32(R & 31)) : R;
        voffA[i] = (unsigned)(R * lda + C) * 2u; voffB[i] = (unsigned)(Rb * K + C) * 2u; }
    const size_t kstep = (size_t)(BK * 2);
    const size_t hstepA = (size_t)HALF * lda * 2, hstepB = (size_t)HALF * K * 2;
    const size_t tstepB = 2 * hstepB;
    const unsigned ldsw = (unsigned)wid * 1024u;
    const int aoff = lds_byte(wr * 64 + fr, fq * 8), boff = lds_byte(wc * 32 + fr, fq * 8);
#define PG8_SA(b, h) (((b) * 2 + (h)) * HTB)
#define PG8_SB(b, h) ((4 + (b) * 2 + (h)) * HTB)
#define PG8_STAGE(bufoff, gbase, voff) do { _Pragma("unroll") for (int _i = 0; _i < 2; ++_i) \
        __builtin_amdgcn_global_load_lds((const unsigned*)((const char*)(gbase) + (voff)[_i]), (PG8_LAS unsigned*)(lds + (bufoff) + ldsw + _i * 8192), 16, 0, 0); } while (0)
#define PG8_LDA(dst, b, h) do { _Pragma("unroll") for (int m = 0; m < 4; ++m) _Pragma("unroll") for (int k = 0; k < 2; ++k) dst[m][k] = *(const PG8_LAS bf16x8*)(lds + PG8_SA(b, h) + aoff + m * 2048 + k * 1024); } while (0)
#define PG8_LDB(dst, b, h) do { _Pragma("unroll") for (int n = 0; n < 2; ++n) _Pragma("unroll") for (int k = 0; k < 2; ++k) dst[n][k] = *(const PG8_LAS bf16x8*)(lds + PG8_SB(b, h) + boff + n * 2048 + k * 1024); } while (0)
#define PG8_MMA(ai, bj, At, Bt) do { __builtin_amdgcn_s_setprio(1); _Pragma("unroll") for (int m = 0; m < 4; ++m) _Pragma("unroll") for (int n = 0; n < 2; ++n) _Pragma("unroll") for (int k = 0; k < 2; ++k) \
        acc[ai][bj][m][n] = __builtin_amdgcn_mfma_f32_16x16x32_bf16(Bt[n][k], At[m][k], acc[ai][bj][m][n], 0, 0, 0); __builtin_amdgcn_s_setprio(0); } while (0)
#define PG8_WAIT_V(n) asm volatile("s_waitcnt vmcnt(" #n ")" ::: "memory")
#define PG8_WAIT_L(n) asm volatile("s_waitcnt lgkmcnt(" #n ")" ::: "memory")
#define PG8_BAR __builtin_amdgcn_s_barrier()
#define PG8_SCHED __builtin_amdgcn_sched_barrier(0)
    Unit cur, nxt; int ui = 0;
    if (!S.next(0, cur)) return;
    f32x4 acc[2][2][4][2];
#pragma unroll
    for (int a = 0; a < 2; ++a)
#pragma unroll
        for (int b = 0; b < 2; ++b)
#pragma unroll
            for (int m = 0; m < 4; ++m)
#pragma unroll
                for (int n = 0; n < 2; ++n) acc[a][b][m][n] = (f32x4){0.f, 0.f, 0.f, 0.f};
    bf16x8 At[4][2], B0[2][2], B1[2][2];
    const char* cA = a_base(g, cur); const char* cB = (const char*)g.Bt + (size_t)cur.pn * tstepB;
    S.a_ready(cur);
    PG8_STAGE(PG8_SB(0, 0), cB, voffB); PG8_STAGE(PG8_SB(0, 1), cB + hstepB, voffB); PG8_STAGE(PG8_SA(0, 0), cA, voffA); PG8_STAGE(PG8_SA(0, 1), cA + hstepA, voffA);
    if (wr == 1) PG8_BAR;
    PG8_WAIT_V(2); PG8_BAR;
    PG8_STAGE(PG8_SB(1, 0), cB + kstep, voffB); PG8_STAGE(PG8_SA(1, 0), cA + kstep, voffA); PG8_STAGE(PG8_SB(1, 1), cB + hstepB + kstep, voffB);
    PG8_WAIT_V(6); PG8_BAR;
    for (;;) {
        const bool has_next = S.next(ui + 1, nxt);
        const char* nA = has_next ? a_base(g, nxt) : cA; const char* nB = has_next ? (const char*)g.Bt + (size_t)nxt.pn * tstepB : cB;
#pragma unroll 1
        for (int t = 0; t < nt; t += 2) {
            const bool last = (t == nt - 2);
            const char* a1 = cA + (size_t)(t + 1) * kstep;
            const char* a2 = last ? nA : cA + (size_t)(t + 2) * kstep; const char* b2 = last ? nB : cB + (size_t)(t + 2) * kstep;
            const char* a3 = a2 + kstep; const char* b3 = b2 + kstep;
            if (last && has_next) S.a_ready(nxt);
            PG8_LDB(B0, 0, 0); PG8_LDB(B1, 0, 1); PG8_SCHED; PG8_LDA(At, 0, 0); PG8_STAGE(PG8_SA(1, 1), a1 + hstepA, voffA);
            PG8_WAIT_V(8); PG8_WAIT_L(0); PG8_BAR; PG8_MMA(0, 0, At, B0); PG8_MMA(0, 1, At, B1); PG8_BAR; PG8_SCHED;
            PG8_LDA(At, 0, 1); PG8_STAGE(PG8_SB(0, 0), b2, voffB); PG8_STAGE(PG8_SB(0, 1), b2 + hstepB, voffB); PG8_STAGE(PG8_SA(0, 0), a2, voffA);
            PG8_WAIT_V(8); PG8_WAIT_L(0); PG8_BAR; PG8_MMA(1, 0, At, B0); PG8_MMA(1, 1, At, B1); PG8_BAR; PG8_SCHED;
            PG8_LDB(B0, 1, 0); PG8_LDB(B1, 1, 1); PG8_SCHED; PG8_LDA(At, 1, 0); PG8_STAGE(PG8_SA(0, 1), a2 + hstepA, voffA);
            PG8_WAIT_V(8); PG8_WAIT_L(0); PG8_BAR; PG8_MMA(0, 0, At, B0); PG8_MMA(0, 1, At, B1); PG8_BAR; PG8_SCHED;
            PG8_LDA(At, 1, 1); PG8_STAGE(PG8_SB(1, 0), b3, voffB); PG8_STAGE(PG8_SB(1, 1), b3 + hstepB, voffB); PG8_STAGE(PG8_SA(1, 0), a3, voffA);
            PG8_WAIT_V(8); PG8_WAIT_L(0); PG8_BAR; PG8_MMA(1, 0, At, B0); PG8_MMA(1, 1, At, B1); PG8_BAR; PG8_SCHED;
        }
        if constexpr (ALIGN_EPI) { if (wr == 0) PG8_BAR; }
        E(acc, cur, wr, wc, fr, fq); S.done(cur);
        if (!has_next) break;
#pragma unroll
        for (int a = 0; a < 2; ++a)
#pragma unroll
            for (int b = 0; b < 2; ++b)
#pragma unroll
                for (int m = 0; m < 4; ++m)
#pragma unroll
                    for (int n = 0; n < 2; ++n) acc[a][b][m][n] = (f32x4){0.f, 0.f, 0.f, 0.f};
        cur = nxt; cA = nA; cB = nB; ++ui;
        if constexpr (ALIGN_EPI) { if (wr == 1) PG8_BAR; }
    }
    PG8_WAIT_V(0);
    if constexpr (!ALIGN_EPI) { if (wr == 0) PG8_BAR; }
    PG8_BAR;
#undef PG8_SA
#undef PG8_SB
#undef PG8_STAGE
#undef PG8_LDA
#undef PG8_LDB
#undef PG8_MMA
#undef PG8_WAIT_V
#undef PG8_WAIT_L
#undef PG8_BAR
#undef PG8_SCHED
}
}

constexpr int NWAVES = 8, NTHREADS = 512;
constexpr int D = 2048, MP = 8192, MS = 1024, M = MP + MS;
constexpr int AW = 1024, EVEN_IN = 5120, DFF = 5632, PLE = 256;
constexpr int N_O1 = 7168, N_O2 = 8192;
constexpr float ALPHA = 1.6817928305074292f;
constexpr float LN_EPS = 1e-5f, GN_EPS = 64e-5f;
constexpr float SB_THRESH = 100.0f;

constexpr size_t OFF_YP = 0, OFF_YS = 16777216, OFF_KP = 18874368, OFF_VP = 35651584, OFF_WKVP = 52428800, OFF_SHP = 52690944, OFF_CVP = 52695040,
                 OFF_KS = 52740096, OFF_VS = 54837248, OFF_VAS = 56934400, OFF_WKVS = 59031552, OFF_SHS = 63225856, OFF_CVS = 63291392, OUT_END = 64012288;

enum { I_XP = 0, I_XS, I_CK, I_CV, I_WKV, I_SHIFT, I_CONV, I_PP, I_PS, I_EWIN, I_LNVG, I_LNVB, I_EWS, I_EBS, I_EWO, I_MU, I_CWR, I_CWK, I_CWV, I_CWO, I_W0, I_W1, I_W2,
       I_A0, I_A1, I_A2, I_V0, I_V1, I_V2, I_G1, I_G2, I_KK, I_KA, I_RK, I_GNG, I_GNB, I_FWIN, I_FCW, I_FCB, I_FWOUT, I_LN1G, I_LN1B, I_LN2G, I_LN2B, I_PLEP, I_PLEG, N_IN };

constexpr size_t MiB = 1u << 20;
constexpr size_t WS_CTL = 0, CTL_ZERO_BYTES = 1 * MiB;
constexpr size_t SZ_WIN = 5120ull * 2048 * 2, SZ_W22 = 2048ull * 2048 * 2, SZ_W1T = 7168ull * 2048 * 2, SZ_W2T = 8192ull * 256 * 2, SZ_FIN = 11264ull * 2048 * 2, SZ_FOUT = 2048ull * 5632 * 2, SZ_WP = 2048ull * 256 * 2;
constexpr size_t WS_WIN = 1 * MiB, WS_WOE = WS_WIN + 2 * SZ_WIN, WS_W1T = WS_WOE + 2 * SZ_W22, WS_W2T = WS_W1T + 2 * SZ_W1T, WS_WOC = WS_W2T + 2 * SZ_W2T,
                 WS_FIN = WS_WOC + 2 * SZ_W22, WS_FOUT = WS_FIN + 4 * SZ_FIN, WS_WG = WS_FOUT + 4 * SZ_FOUT, WS_WP = WS_WG + 4 * SZ_W22, WS_WEND = WS_WP + 4 * SZ_WP;
constexpr size_t SZ_X32 = (size_t)M * D * 4, SZ_X16 = (size_t)M * D * 2, SZ_PB = (size_t)M * PLE * 2, SZ_H16 = (size_t)M * 1024 * 2, SZ_FF16 = (size_t)M * DFF * 2, SZ_H1 = (size_t)M * 512 * 2;
constexpr size_t WS_X = WS_WEND, WS_XB = WS_X + SZ_X32, WS_Y = WS_XB + 2 * SZ_X16,
                 WS_PB = WS_Y + SZ_X32, WS_V1 = WS_PB + 4 * SZ_PB, WS_SCR = WS_V1 + SZ_X32;
constexpr size_t WS_U = WS_SCR, WS_ZV = WS_U + SZ_H16, WS_QF = WS_ZV + SZ_H16, WS_AO = WS_QF + 2 * SZ_H16, WS_EVEN_END = WS_AO + SZ_X16;
constexpr size_t WS_MIX = WS_SCR, WS_R = WS_MIX + 6 * SZ_X16, WS_K = WS_R + SZ_X32, WS_V3 = WS_K + SZ_X32, WS_H1 = WS_V3 + SZ_X32, WS_WD = WS_H1 + SZ_H1, WS_AA = WS_WD + SZ_X32,
                 WS_VG = WS_AA + SZ_X16, WS_GG = WS_VG + SZ_X16, WS_YS = WS_GG + SZ_X16, WS_YG = WS_YS + SZ_X32, WS_ODD_END = WS_YG + SZ_X16;
constexpr size_t WS_HG = WS_SCR, WS_HU = WS_HG + SZ_FF16, WS_ACT = WS_HU + SZ_FF16, WS_PPF = WS_ACT + SZ_FF16, WS_FFN_END = WS_PPF + SZ_X32;
constexpr size_t WS_END = WS_ODD_END > WS_FFN_END ? (WS_ODD_END > WS_EVEN_END ? WS_ODD_END : WS_EVEN_END) : (WS_FFN_END > WS_EVEN_END ? WS_FFN_END : WS_EVEN_END);
static_assert(WS_END <= 1568358400ull, "workspace map exceeds the guaranteed d_ws size");
constexpr int CW_BAR = 4096;

constexpr int LDS_BYTES = 147456;
constexpr int LDSCTL_OFF = LDS_BYTES - 256;

#define GAS __attribute__((address_space(1)))
#define LAS __attribute__((address_space(3)))
typedef unsigned short bf16;
typedef unsigned v4u __attribute__((ext_vector_type(4)));
typedef unsigned v2u __attribute__((ext_vector_type(2)));
typedef float f32x4 __attribute__((ext_vector_type(4)));
typedef float f32x2 __attribute__((ext_vector_type(2)));
#define LDS_WAIT() asm volatile("s_waitcnt lgkmcnt(0)" ::: "memory")
#define VM_WAIT() asm volatile("s_waitcnt vmcnt(0)" ::: "memory")
using pg8::cvt_pk_bf16;
__device__ __forceinline__ float bf_lo(unsigned w) { return __uint_as_float(w << 16); }
__device__ __forceinline__ float bf_hi(unsigned w) { return __uint_as_float(w & 0xffff0000u); }
__device__ __forceinline__ float sigmoid_f(float x) { return 1.f / (1.f + __expf(-x)); }
__device__ __forceinline__ float tanh_f(float x) { return 1.f - 2.f / (1.f + __expf(2.f * x)); }
__device__ __forceinline__ float gelu_f(float x) { const float u = 0.7978845608028654f * (x + 0.044715f * x * x * x); return x / (1.f + __expf(-2.f * u)); }
__device__ __forceinline__ f32x4 gelu4(f32x4 v) { return (f32x4){gelu_f(v.x), gelu_f(v.y), gelu_f(v.z), gelu_f(v.w)}; }
__device__ __forceinline__ v2u pk4(f32x4 v) { v2u r; r.x = cvt_pk_bf16(v.x, v.y); r.y = cvt_pk_bf16(v.z, v.w); return r; }
template <int CTRL> __device__ __forceinline__ float dpp_f(float x) { return __builtin_bit_cast(float, __builtin_amdgcn_update_dpp(0, __builtin_bit_cast(int, x), CTRL, 0xF, 0xF, true)); }
__device__ __forceinline__ float reduce8(float x) { x += dpp_f<0xB1>(x); x += dpp_f<0x4E>(x); x += dpp_f<0x141>(x); return x; }
__device__ __forceinline__ float reduce16(float x) { x = reduce8(x); x += dpp_f<0x140>(x); return x; }
__device__ __forceinline__ float wave_sum(float x) { x = reduce16(x); x += __shfl_xor(x, 16); x += __shfl_xor(x, 32); return x; }

#define XLAS LAS
#define XB_TMO      128
#define XB_XCNT(j)  (256  + 64 * (j))
#define XB_XSUB(j)  (1280 + 64 * (j))
#define XB_XGEN(j)  (2304 + 64 * (j))
#define XB_TOP      3328
#define XB_TOPGEN   3392
#define XCD_BAR_WORDS 3456
#define XB_SPIN_CAP (1u << 18)
__device__ __forceinline__ unsigned xb_ld(unsigned* p)              { return __hip_atomic_load(p, __ATOMIC_RELAXED, __HIP_MEMORY_SCOPE_AGENT); }
__device__ __forceinline__ unsigned xb_add(unsigned* p, unsigned v) { return __hip_atomic_fetch_add(p, v, __ATOMIC_RELAXED, __HIP_MEMORY_SCOPE_AGENT); }
__device__ __forceinline__ unsigned xb_xcc_id() { return (unsigned)__builtin_amdgcn_s_getreg((3 << 11) | 20) & 0xFu; }
#define XB_SPIN(cond, bar) do { unsigned _sp = 0; while (cond) { __builtin_amdgcn_s_sleep(1); \
    if ((++_sp & 255u) == 0u) { if (xb_ld(&(bar)[XB_TMO])) break; if (_sp > XB_SPIN_CAP) { atomicAdd(&(bar)[XB_TMO], 1u); break; } } } } while (0)
struct XcdBarrier { unsigned* bar; unsigned x; volatile LAS unsigned* st; };
__device__ __forceinline__ XcdBarrier xcd_barrier_post(unsigned* bar, volatile LAS unsigned* st) {
    XcdBarrier b; b.bar = bar; b.x = xb_xcc_id(); b.st = st;
    if (threadIdx.x == 0) (void)xb_add(&bar[XB_XCNT(b.x)], 1u);
    return b;
}
__device__ __forceinline__ void xcd_barrier_complete(unsigned* bar, unsigned x, unsigned& nloc, unsigned& nx) {
    const unsigned G = gridDim.x * gridDim.y * gridDim.z;
    unsigned sum, cnt, mine, sp = 0u;
    for (;;) {
        sum = 0u; cnt = 0u; mine = 0u;
#pragma unroll
        for (unsigned j = 0; j < 16; ++j) { const unsigned c = xb_ld(&bar[XB_XCNT(j)]); sum += c; cnt += (c > 0u) ? 1u : 0u; mine = (j == x) ? c : mine; }
        if (sum == G) break;
        __builtin_amdgcn_s_sleep(1);
        if ((++sp & 255u) == 0u) { if (xb_ld(&bar[XB_TMO])) break; if (sp > XB_SPIN_CAP) { atomicAdd(&bar[XB_TMO], 1u); break; } }
    }
    nloc = mine > 0u ? mine : 1u; nx = cnt > 0u ? cnt : 1u;
}
__device__ __forceinline__ void xcd_barrier(const XcdBarrier& b) {
    asm volatile("s_waitcnt vmcnt(0)" ::: "memory");
    __syncthreads();
    if (threadIdx.x == 0) {
        unsigned* bar = b.bar;
        __builtin_amdgcn_s_waitcnt(0);
        unsigned nloc = b.st[0], nx = b.st[1];
        if (nloc == 0u) { xcd_barrier_complete(bar, b.x, nloc, nx); b.st[0] = nloc; b.st[1] = nx; }
        const unsigned old = xb_add(&bar[XB_XSUB(b.x)], 1u);
        const unsigned gen = old / nloc;
        if (old + 1u == (gen + 1u) * nloc) {
            __builtin_amdgcn_fence(__ATOMIC_RELEASE, "agent");
            asm volatile("s_waitcnt vmcnt(0)" ::: "memory");
            const unsigned og = xb_add(&bar[XB_TOP], 1u);
            const unsigned tg = og / nx;
            if (og + 1u == (tg + 1u) * nx) xb_add(&bar[XB_TOPGEN], 1u);
            else XB_SPIN(xb_ld(&bar[XB_TOPGEN]) == tg, bar);
            __builtin_amdgcn_fence(__ATOMIC_ACQUIRE, "agent");
            xb_add(&bar[XB_XGEN(b.x)], 1u);
            asm volatile("s_waitcnt vmcnt(0)" ::: "memory");
        } else {
            XB_SPIN(xb_ld(&bar[XB_XGEN(b.x)]) == gen, bar);
            __builtin_amdgcn_fence(__ATOMIC_ACQUIRE, "agent");
            asm volatile("s_waitcnt vmcnt(0)" ::: "memory");
        }
    }
    __syncthreads();
}

struct Args { const float* in[N_IN]; float* out; unsigned char* ws; int ph_lo, ph_hi; };

__device__ __forceinline__ const float* inp(const Args& a, int i) { int k = i; asm volatile("" : "+s"(k)); return a.in[k]; }
__device__ __forceinline__ unsigned char* wsp(const Args& a) { size_t z = 0; asm volatile("" : "+s"(z)); return a.ws + z; }
__device__ __forceinline__ float* outp(const Args& a) { size_t z = 0; asm volatile("" : "+s"(z)); return a.out + z; }

__device__ __forceinline__ bool seq_start(int m) { return m == 0 || (m >= MP && ((m - MP) & 63) == 0); }

template <class F> __device__ __forceinline__ void epi_each(const f32x4 (&acc)[2][2][4][2], const pg8::Unit& u, int wr, int wc, int fr, int fq, F&& f) {
#pragma unroll
    for (int ai = 0; ai < 2; ++ai)
#pragma unroll
        for (int m = 0; m < 4; ++m) { const int row = u.pm * 256 + ai * 128 + wr * 64 + m * 16 + fr;
#pragma unroll
            for (int bj = 0; bj < 2; ++bj)
#pragma unroll
                for (int n = 0; n < 2; ++n) f(row, u.pn * 256 + bj * 128 + wc * 32 + n * 16 + fq * 4, acc[ai][bj][m][n]);
            asm volatile("" ::: "memory"); }
}
template <class F> __device__ __forceinline__ void epi_each8(const f32x4 (&acc)[2][2][4][2], const pg8::Unit& u, int wr, int wc, int fr, int fq, F&& f) {
#pragma unroll
    for (int ai = 0; ai < 2; ++ai)
#pragma unroll
        for (int m = 0; m < 4; ++m) { const int row = u.pm * 256 + ai * 128 + wr * 64 + m * 16 + fr;
#pragma unroll
            for (int bj = 0; bj < 2; ++bj) f(row, u.pn * 256 + bj * 128 + wc * 32 + fq * 8, acc[ai][bj][m][0], acc[ai][bj][m][1]);
            asm volatile("" ::: "memory"); }
}

struct EpiEvenIn {
    static constexpr bool PERM = false;
    bf16* U; bf16* ZV; float* QF; float* out; int j;
    __device__ __forceinline__ void operator()(const f32x4 (&acc)[2][2][4][2], const pg8::Unit& u, int wr, int wc, int fr, int fq) const {
        const int grp = u.pn >> 2;
        if (grp == 0) epi_each(acc, u, wr, wc, fr, fq, [&](int row, int col, f32x4 v) { *(v2u*)(U + (size_t)row * 1024 + col) = pk4(gelu4(v)); });
        else if (grp == 1) epi_each(acc, u, wr, wc, fr, fq, [&](int row, int col, f32x4 v) { *(v2u*)(ZV + (size_t)row * 1024 + (col - 1024)) = pk4(gelu4(v)); });
        else if (grp == 2) epi_each(acc, u, wr, wc, fr, fq, [&](int row, int col, f32x4 v) { *(f32x4*)(QF + (size_t)row * 1024 + (col - 2048)) = v; });
        else { float* bp = out + (grp == 3 ? OFF_KP : OFF_VP) + (size_t)j * MP * 1024; float* bs = out + (grp == 3 ? OFF_KS : OFF_VS) + (size_t)j * MS * 1024; const int c0 = grp == 3 ? 3072 : 4096;
            epi_each(acc, u, wr, wc, fr, fq, [&](int row, int col, f32x4 v) { float* d = row < MP ? bp + (size_t)row * 1024 : bs + (size_t)(row - MP) * 1024; *(f32x4*)(d + (col - c0)) = v; }); }
    }
};
struct EpiResid {
    static constexpr bool PERM = false;
    const float* X; float* Y;
    __device__ __forceinline__ void operator()(const f32x4 (&acc)[2][2][4][2], const pg8::Unit& u, int wr, int wc, int fr, int fq) const {
        epi_each(acc, u, wr, wc, fr, fq, [&](int row, int col, f32x4 v) { const size_t o = (size_t)row * D + col; const f32x4 x = *(const f32x4*)(X + o); *(f32x4*)(Y + o) = x * ALPHA + v; });
    }
};
struct EpiFfnIn {
    static constexpr bool PERM = true;
    bf16* HG; bf16* HU; float* out; int layer;
    __device__ __forceinline__ void operator()(const f32x4 (&acc)[2][2][4][2], const pg8::Unit& u, int wr, int wc, int fr, int fq) const {
        if (u.pn < 22) { float* cp = out + OFF_CVP + (size_t)layer * 2 * DFF; float* cs = out + OFF_CVS + (size_t)layer * 16 * 2 * DFF;
            epi_each8(acc, u, wr, wc, fr, fq, [&](int row, int col, f32x4 v0, f32x4 v1) {
                v4u w; w.x = cvt_pk_bf16(v0.x, v0.y); w.y = cvt_pk_bf16(v0.z, v0.w); w.z = cvt_pk_bf16(v1.x, v1.y); w.w = cvt_pk_bf16(v1.z, v1.w);
                *(v4u*)(HG + (size_t)row * DFF + col) = w;
                float* d = nullptr;
                if (row < MP) { if (row >= MP - 2) d = cp + (size_t)(row - (MP - 2)) * DFF; }
                else { const int t = (row - MP) & 63, b = (row - MP) >> 6; if (t >= 62) d = cs + ((size_t)b * 2 + (t - 62)) * DFF; }
                if (d) { *(f32x4*)(d + col) = v0; *(f32x4*)(d + col + 4) = v1; } }); }
        else epi_each8(acc, u, wr, wc, fr, fq, [&](int row, int col, f32x4 v0, f32x4 v1) {
                v4u w; w.x = cvt_pk_bf16(v0.x, v0.y); w.y = cvt_pk_bf16(v0.z, v0.w); w.z = cvt_pk_bf16(v1.x, v1.y); w.w = cvt_pk_bf16(v1.z, v1.w);
                *(v4u*)(HU + (size_t)row * DFF + (col - DFF)) = w; });
    }
};
struct EpiF32 {
    static constexpr bool PERM = false;
    float* C; int ldc;
    __device__ __forceinline__ void operator()(const f32x4 (&acc)[2][2][4][2], const pg8::Unit& u, int wr, int wc, int fr, int fq) const {
        epi_each(acc, u, wr, wc, fr, fq, [&](int row, int col, f32x4 v) { *(f32x4*)(C + (size_t)row * ldc + col) = v; });
    }
};
struct EpiPle {
    static constexpr bool PERM = false;
    float* X; bf16* XB; const float* PPF; float* yout;
    __device__ __forceinline__ void operator()(const f32x4 (&acc)[2][2][4][2], const pg8::Unit& u, int wr, int wc, int fr, int fq) const {
        epi_each(acc, u, wr, wc, fr, fq, [&](int row, int col, f32x4 v) { const size_t o = (size_t)row * D + col; const f32x4 x = *(const f32x4*)(X + o), pp = *(const f32x4*)(PPF + o);
            f32x4 r; r.x = x.x + sigmoid_f(v.x) * pp.x; r.y = x.y + sigmoid_f(v.y) * pp.y; r.z = x.z + sigmoid_f(v.z) * pp.z; r.w = x.w + sigmoid_f(v.w) * pp.w;
            *(f32x4*)(X + o) = r; *(v2u*)(XB + o) = pk4(r); if (yout) *(f32x4*)(yout + o) = r; });
    }
};
struct EpiO1 {
    static constexpr bool PERM = false;
    float* R; float* K; float* V; bf16* H1;
    __device__ __forceinline__ void operator()(const f32x4 (&acc)[2][2][4][2], const pg8::Unit& u, int wr, int wc, int fr, int fq) const {
        const int pn = u.pn;
        if (pn < 8) epi_each(acc, u, wr, wc, fr, fq, [&](int row, int col, f32x4 v) { *(f32x4*)(R + (size_t)row * D + col) = v; });
        else if (pn < 16) epi_each(acc, u, wr, wc, fr, fq, [&](int row, int col, f32x4 v) { *(f32x4*)(K + (size_t)row * D + (col - 2048)) = v; });
        else if (pn < 24) epi_each(acc, u, wr, wc, fr, fq, [&](int row, int col, f32x4 v) { *(f32x4*)(V + (size_t)row * D + (col - 4096)) = v; });
        else if (pn == 24) epi_each(acc, u, wr, wc, fr, fq, [&](int row, int col, f32x4 v) { const int lc = col - 24 * 256; if (lc < 96) { f32x4 t = (f32x4){tanh_f(v.x), tanh_f(v.y), tanh_f(v.z), tanh_f(v.w)}; *(v2u*)(H1 + (size_t)row * 512 + lc) = pk4(t); } });
        else if (pn == 25) epi_each(acc, u, wr, wc, fr, fq, [&](int row, int col, f32x4 v) { const int lc = col - 25 * 256; if (lc < 96) *(v2u*)(H1 + (size_t)row * 512 + 96 + lc) = pk4(v); });
        else if (pn == 26) epi_each(acc, u, wr, wc, fr, fq, [&](int row, int col, f32x4 v) { const int lc = col - 26 * 256; if (lc < 64) *(v2u*)(H1 + (size_t)row * 512 + 192 + lc) = pk4(v); });
        else epi_each(acc, u, wr, wc, fr, fq, [&](int row, int col, f32x4 v) { const int lc = col - 27 * 256; f32x4 t = (f32x4){sigmoid_f(v.x), sigmoid_f(v.y), sigmoid_f(v.z), sigmoid_f(v.w)}; *(v2u*)(H1 + (size_t)row * 512 + 256 + lc) = pk4(t); });
    }
};
struct EpiO2 {
    static constexpr bool PERM = false;
    float* WD; bf16* AA; bf16* VG; bf16* GG; const float* w0; const float* a0; const float* v0;
    __device__ __forceinline__ void operator()(const f32x4 (&acc)[2][2][4][2], const pg8::Unit& u, int wr, int wc, int fr, int fq) const {
        const int grp = u.pn >> 3;
        if (grp == 0) epi_each(acc, u, wr, wc, fr, fq, [&](int row, int col, f32x4 v) { const f32x4 b = *(const f32x4*)(w0 + col); f32x4 r;
            r.x = __expf(-0.6065306597126334f * sigmoid_f(b.x + v.x)); r.y = __expf(-0.6065306597126334f * sigmoid_f(b.y + v.y)); r.z = __expf(-0.6065306597126334f * sigmoid_f(b.z + v.z)); r.w = __expf(-0.6065306597126334f * sigmoid_f(b.w + v.w));
            *(f32x4*)(WD + (size_t)row * D + col) = r; });
        else if (grp == 1) epi_each(acc, u, wr, wc, fr, fq, [&](int row, int col, f32x4 v) { const int c = col - 2048; const f32x4 b = *(const f32x4*)(a0 + c);
            f32x4 r = (f32x4){sigmoid_f(b.x + v.x), sigmoid_f(b.y + v.y), sigmoid_f(b.z + v.z), sigmoid_f(b.w + v.w)}; *(v2u*)(AA + (size_t)row * D + c) = pk4(r); });
        else if (grp == 2) { if (v0) epi_each(acc, u, wr, wc, fr, fq, [&](int row, int col, f32x4 v) { const int c = col - 4096; const f32x4 b = *(const f32x4*)(v0 + c);
            f32x4 r = (f32x4){sigmoid_f(b.x + v.x), sigmoid_f(b.y + v.y), sigmoid_f(b.z + v.z), sigmoid_f(b.w + v.w)}; *(v2u*)(VG + (size_t)row * D + c) = pk4(r); }); }
        else epi_each(acc, u, wr, wc, fr, fq, [&](int row, int col, f32x4 v) { const int c = col - 6144; *(v2u*)(GG + (size_t)row * D + c) = pk4(v); });
    }
};

struct Ctx { int tid, lane, wave, gw, NGW, gtid, NT; LAS unsigned char* lds; };
__device__ __forceinline__ Ctx make_ctx(LAS unsigned char* lds) { Ctx c; int t = threadIdx.x; asm volatile("" : "+v"(t)); c.tid = t; c.lane = t & 63; c.wave = __builtin_amdgcn_readfirstlane(t >> 6); c.lds = lds;
    c.gw = blockIdx.x * NWAVES + c.wave; c.NGW = gridDim.x * NWAVES; c.gtid = blockIdx.x * NTHREADS + t; c.NT = gridDim.x * NTHREADS; return c; }

struct TJD { int src_idx; unsigned long long src_off, dst_off; int K, N, row_off; };
#define TJ_ODD(j)  {I_EWIN, (unsigned long long)(j) * 2048 * 5120, WS_WIN + (j) * SZ_WIN, 2048, 5120, 0}, {I_EWO, (unsigned long long)(j) * 2048 * 2048, WS_WOE + (j) * SZ_W22, 2048, 2048, 0}, \
    {I_CWR, (unsigned long long)(j) * 2048 * 2048, WS_W1T + (j) * SZ_W1T, 2048, 2048, 0}, {I_CWK, (unsigned long long)(j) * 2048 * 2048, WS_W1T + (j) * SZ_W1T, 2048, 2048, 2048}, {I_CWV, (unsigned long long)(j) * 2048 * 2048, WS_W1T + (j) * SZ_W1T, 2048, 2048, 4096}, \
    {I_W1, (unsigned long long)(j) * 2048 * 96, WS_W1T + (j) * SZ_W1T, 2048, 96, 6144}, {I_A1, (unsigned long long)(j) * 2048 * 96, WS_W1T + (j) * SZ_W1T, 2048, 96, 6400}, {I_G1, (unsigned long long)(j) * 2048 * 256, WS_W1T + (j) * SZ_W1T, 2048, 256, 6912}, \
    {I_CWO, (unsigned long long)(j) * 2048 * 2048, WS_WOC + (j) * SZ_W22, 2048, 2048, 0}
#define TJ_FFN(i)  {I_FWIN, (unsigned long long)(i) * 2048 * 11264, WS_FIN + (i) * SZ_FIN, 2048, 11264, 0}, {I_FWOUT, (unsigned long long)(i) * 5632 * 2048, WS_FOUT + (i) * SZ_FOUT, 5632, 2048, 0}, \
    {I_PLEG, (unsigned long long)(i) * 2048 * 2048, WS_WG + (i) * SZ_W22, 2048, 2048, 0}, {I_PLEP, (unsigned long long)(i) * 256 * 2048, WS_WP + (i) * SZ_WP, 256, 2048, 0}
__device__ const TJD tj_table[35] = { TJ_ODD(0), TJ_ODD(1), {I_V1, 0ull, WS_W1T + 1 * SZ_W1T, 2048, 64, 6656}, TJ_FFN(0), TJ_FFN(1), TJ_FFN(2), TJ_FFN(3) };
constexpr int N_TJOBS = 35;
__device__ __forceinline__ void transpose_item(const float* W, int K, int N, bf16* WT, int row_off, LAS float* scr, int item, int lane) {
    const int nblk = N / 32, kb = item / nblk, nb = item % nblk, k0 = 64 * kb, n0 = 32 * nb;
#pragma unroll 8
    for (int i = 0; i < 32; ++i) { const int kk = 2 * i + (lane >> 5); scr[kk * 33 + (lane & 31)] = W[(size_t)(k0 + kk) * N + n0 + (lane & 31)]; }
    LDS_WAIT(); asm volatile("" ::: "memory");
    const int c = lane & 7;
#pragma unroll
    for (int j = 0; j < 4; ++j) { const int n = (lane >> 3) + 8 * j; const LAS float* s = scr + (8 * c) * 33 + n;
        v4u o; o.x = cvt_pk_bf16(s[0 * 33], s[1 * 33]); o.y = cvt_pk_bf16(s[2 * 33], s[3 * 33]); o.z = cvt_pk_bf16(s[4 * 33], s[5 * 33]); o.w = cvt_pk_bf16(s[6 * 33], s[7 * 33]);
        *(v4u*)(WT + (size_t)(row_off + n0 + n) * K + k0 + 8 * c) = o; }
    LDS_WAIT(); asm volatile("" ::: "memory");
}
__device__ __forceinline__ void p0_prologue(const Args& a, const Ctx& c) {
    LAS float* scr = (LAS float*)(c.lds + c.wave * 16384);
    for (int job = 0; job < N_TJOBS; ++job) { const TJD t = tj_table[job]; const int nit = (t.K / 64) * (t.N / 32); const float* src = a.in[t.src_idx] + t.src_off; bf16* dst = (bf16*)(wsp(a) + t.dst_off);
        for (int it = c.gw; it < nit; it += c.NGW) transpose_item(src, t.K, t.N, dst, t.row_off, scr, it, c.lane); }
    const float* pw2 = inp(a, I_W2); const float* pa2 = inp(a, I_A2); const float* pv2 = inp(a, I_V2); const float* pg2 = inp(a, I_G2);
    for (int idx = c.gtid; idx < 2 * 8192 * 32; idx += c.NT) { const int j = idx / (8192 * 32), r = idx % (8192 * 32), k8 = r / 8192, n = r % 8192, k0 = k8 * 8;
        float v[8];
#pragma unroll
        for (int e = 0; e < 8; ++e) { const int k = k0 + e; float x = 0.f;
            if (n < 2048) { if (k < 96) x = pw2[((size_t)j * 96 + k) * 2048 + n]; }
            else if (n < 4096) { if (k >= 96 && k < 192) x = pa2[((size_t)j * 96 + (k - 96)) * 2048 + (n - 2048)]; }
            else if (n < 6144) { if (j == 1 && k >= 192) x = pv2[(size_t)(k - 192) * 2048 + (n - 4096)]; }
            else x = pg2[((size_t)j * 256 + k) * 2048 + (n - 6144)];
            v[e] = x; }
        v4u o; o.x = cvt_pk_bf16(v[0], v[1]); o.y = cvt_pk_bf16(v[2], v[3]); o.z = cvt_pk_bf16(v[4], v[5]); o.w = cvt_pk_bf16(v[6], v[7]);
        *(v4u*)((bf16*)(wsp(a) + WS_W2T + j * SZ_W2T) + (size_t)n * 256 + k0) = o; }
    float* X = (float*)(wsp(a) + WS_X); bf16* XB = (bf16*)(wsp(a) + WS_XB);
    const float* pxp = inp(a, I_XP); const float* pxs = inp(a, I_XS);
    for (int m = c.gw; m < M; m += c.NGW) { const float* src = m < MP ? pxp + (size_t)m * D : pxs + (size_t)(m - MP) * D;
#pragma unroll
        for (int q = 0; q < 8; ++q) { const int col = (c.lane + 64 * q) * 4; const f32x4 v = *(const f32x4*)(src + col); *(f32x4*)(X + (size_t)m * D + col) = v; *(v2u*)(XB + (size_t)m * D + col) = pk4(v); } }
    bf16* PB = (bf16*)(wsp(a) + WS_PB);
    const float* ppp = inp(a, I_PP); const float* pps = inp(a, I_PS);
    for (int idx = c.gtid; idx < 4 * M * 32; idx += c.NT) { const int i = idx / (M * 32), r = idx % (M * 32), m = r / 32, c8 = (r % 32) * 8;
        const float* src = m < MP ? ppp + ((size_t)i * MP + m) * PLE + c8 : pps + ((size_t)i * MS + (m - MP)) * PLE + c8;
        const f32x4 v0 = *(const f32x4*)src, v1 = *(const f32x4*)(src + 4);
        v4u o; o.x = cvt_pk_bf16(v0.x, v0.y); o.y = cvt_pk_bf16(v0.z, v0.w); o.z = cvt_pk_bf16(v1.x, v1.y); o.w = cvt_pk_bf16(v1.z, v1.w);
        *(v4u*)(PB + ((size_t)i * M + m) * PLE + c8) = o; }
}

__device__ __forceinline__ void ln_phase(const float* Y, const float* g, const float* b, float* X, bf16* XB, const Ctx& c) {
    for (int m = c.gw; m < M; m += c.NGW) {
        const f32x4* yr = (const f32x4*)(Y + (size_t)m * D) + c.lane; f32x4 v[8]; float s = 0.f;
#pragma unroll
        for (int q = 0; q < 8; ++q) { v[q] = yr[64 * q]; s += (v[q].x + v[q].y) + (v[q].z + v[q].w); }
        const float mean = wave_sum(s) * (1.f / D); float s2 = 0.f;
#pragma unroll
        for (int q = 0; q < 8; ++q) { v[q] = v[q] - mean; s2 += (v[q].x * v[q].x + v[q].y * v[q].y) + (v[q].z * v[q].z + v[q].w * v[q].w); }
        const float rstd = 1.f / sqrtf(wave_sum(s2) * (1.f / D) + LN_EPS);
#pragma unroll
        for (int q = 0; q < 8; ++q) { const int col = (c.lane + 64 * q) * 4; const f32x4 g4 = *(const f32x4*)(g + col), b4 = *(const f32x4*)(b + col); const f32x4 o = v[q] * rstd * g4 + b4;
            *(f32x4*)(X + (size_t)m * D + col) = o; *(v2u*)(XB + (size_t)m * D + col) = pk4(o); }
    }
}

__device__ __forceinline__ void mix_phase(const Args& a, int j, const Ctx& c) {
    const float* X = (const float*)(wsp(a) + WS_X); bf16* MIX = (bf16*)(wsp(a) + WS_MIX); const float* mu = inp(a, I_MU) + (size_t)j * 6 * D; const float* shin = inp(a, I_SHIFT);
    for (int m = c.gw; m < M; m += c.NGW) {
        const float* xr = X + (size_t)m * D; const float* xp = xr - D; bool zero_prev = false;
        if (seq_start(m)) { if (m == 0) zero_prev = true; else xp = shin + ((size_t)j * 16 + ((m - MP) >> 6)) * D; }
        float* sh = nullptr;
        if (m == MP - 1) sh = outp(a) + OFF_SHP + (size_t)j * D; else if (m >= MP && ((m - MP) & 63) == 63) sh = outp(a) + OFF_SHS + ((size_t)j * 16 + ((m - MP) >> 6)) * D;
#pragma unroll
        for (int q = 0; q < 8; ++q) { const int col = (c.lane + 64 * q) * 4; const f32x4 x = *(const f32x4*)(xr + col); f32x4 p = (f32x4){0.f, 0.f, 0.f, 0.f}; if (!zero_prev) p = *(const f32x4*)(xp + col);
            const f32x4 dx = p - x;
#pragma unroll
            for (int s = 0; s < 6; ++s) { const f32x4 mu4 = *(const f32x4*)(mu + s * D + col); *(v2u*)(MIX + ((size_t)s * M + m) * D + col) = pk4(x + dx * mu4); }
            if (sh) *(f32x4*)(sh + col) = x; }
    }
}

__device__ __forceinline__ void unpack8(v4u w, float (&f)[8]) { f[0] = bf_lo(w.x); f[1] = bf_hi(w.x); f[2] = bf_lo(w.y); f[3] = bf_hi(w.y); f[4] = bf_lo(w.z); f[5] = bf_hi(w.z); f[6] = bf_lo(w.w); f[7] = bf_hi(w.w); }
__device__ __forceinline__ void load8f(const float* p, float (&f)[8]) { const f32x4 a = *(const f32x4*)p, b = *(const f32x4*)(p + 4); f[0] = a.x; f[1] = a.y; f[2] = a.z; f[3] = a.w; f[4] = b.x; f[5] = b.y; f[6] = b.z; f[7] = b.w; }
__device__ __forceinline__ void act_phase(const Args& a, int layer, const Ctx& c) {
    const bf16* HG = (const bf16*)(wsp(a) + WS_HG); const bf16* HU = (const bf16*)(wsp(a) + WS_HU); bf16* ACT = (bf16*)(wsp(a) + WS_ACT);
    const float* cw = inp(a, I_FCW) + (size_t)layer * 3 * DFF; const float* cb = inp(a, I_FCB) + (size_t)layer * DFF; const float* cst = inp(a, I_CONV);
    constexpr int C8 = DFF / 8;
    for (int idx = c.gtid; idx < M * C8; idx += c.NT) { const int row = idx / C8, col = (idx % C8) * 8;
        const int t = row < MP ? row : ((row - MP) & 63); const float* cprev = row < MP ? nullptr : cst + (((size_t)layer * 16 + ((row - MP) >> 6)) * 2) * DFF;
        float h2[8], h1[8], h0[8], hu[8], w0[8], w1[8], w2[8], bb[8];
        unpack8(*(const v4u*)(HG + (size_t)row * DFF + col), h2); unpack8(*(const v4u*)(HU + (size_t)row * DFF + col), hu);
        if (t >= 1) unpack8(*(const v4u*)(HG + (size_t)(row - 1) * DFF + col), h1);
        else if (cprev) load8f(cprev + DFF + col, h1);
        else {
#pragma unroll
            for (int e = 0; e < 8; ++e) h1[e] = 0.f; }
        if (t >= 2) unpack8(*(const v4u*)(HG + (size_t)(row - 2) * DFF + col), h0);
        else if (cprev) load8f(cprev + (t == 1 ? DFF : 0) + col, h0);
        else {
#pragma unroll
            for (int e = 0; e < 8; ++e) h0[e] = 0.f; }
        load8f(cw + col, w0); load8f(cw + DFF + col, w1); load8f(cw + 2 * DFF + col, w2); load8f(cb + col, bb);
        float o[8];
#pragma unroll
        for (int e = 0; e < 8; ++e) { const float hc = bb[e] + h0[e] * w0[e] + h1[e] * w1[e] + h2[e] * w2[e]; o[e] = gelu_f(hc) * hu[e]; }
        v4u w; w.x = cvt_pk_bf16(o[0], o[1]); w.y = cvt_pk_bf16(o[2], o[3]); w.z = cvt_pk_bf16(o[4], o[5]); w.w = cvt_pk_bf16(o[6], o[7]);
        *(v4u*)(ACT + (size_t)row * DFF + col) = w; }
}

__device__ __forceinline__ void spatial_task(const Args& a, int j, int row0, int n, int h, const Ctx& c) {
    LAS float* vn = (LAS float*)c.lds;
    LAS float* Wl = vn + 128 * 128;
    LAS float* st = Wl + 128 * 132;
    const bf16* ZV = (const bf16*)(wsp(a) + WS_ZV); const bf16* U = (const bf16*)(wsp(a) + WS_U); bf16* AO = (bf16*)(wsp(a) + WS_AO);
    const float* lg = inp(a, I_LNVG) + (size_t)j * AW; const float* lb = inp(a, I_LNVB) + (size_t)j * AW;
    const float* Wg = inp(a, I_EWS) + ((size_t)j * 8 + h) * 128 * 128; const float* bs = inp(a, I_EBS) + ((size_t)j * 8 + h) * 128;
    for (int rr = 0; rr < 16; ++rr) { const int r = c.wave * 16 + rr; if (r < n) {
        const v4u* zr = (const v4u*)(ZV + (size_t)(row0 + r) * AW) + c.lane * 2; float f[16]; { float t8[8]; unpack8(zr[0], t8);
#pragma unroll
            for (int e = 0; e < 8; ++e) f[e] = t8[e]; unpack8(zr[1], t8);
#pragma unroll
            for (int e = 0; e < 8; ++e) f[8 + e] = t8[e]; }
        float s = 0.f;
#pragma unroll
        for (int e = 0; e < 16; ++e) s += f[e];
        const float mean = wave_sum(s) * (1.f / AW); float s2 = 0.f;
#pragma unroll
        for (int e = 0; e < 16; ++e) { const float d = f[e] - mean; s2 += d * d; }
        const float rstd = 1.f / sqrtf(wave_sum(s2) * (1.f / AW) + LN_EPS);
        if (c.lane == 0) { st[r * 2] = mean; st[r * 2 + 1] = rstd; } } }
    for (int k = 0; k < 32; ++k) { const int idx = c.tid + k * NTHREADS, t = idx >> 7, s = idx & 127; Wl[t * 132 + s] = Wg[idx]; }
    __syncthreads();
    float* vaout = (row0 >= MP) ? outp(a) + OFF_VAS + (size_t)j * MS * AW + (size_t)(row0 - MP) * AW + h * 128 : nullptr;
    for (int k = 0; k < 32; ++k) { const int idx = c.tid + k * NTHREADS, s = idx >> 7, cc = idx & 127;
        if (s < n) { const float z = __uint_as_float((unsigned)ZV[(size_t)(row0 + s) * AW + h * 128 + cc] << 16);
            const float v = (z - st[s * 2]) * st[s * 2 + 1] * lg[h * 128 + cc] + lb[h * 128 + cc]; vn[s * 128 + cc] = v; if (vaout) vaout[(size_t)s * AW + cc] = v; } }
    __syncthreads();
    const int t = c.tid >> 2, cq = c.tid & 3;
    if (t < n) { const int s_end = (t < 64) ? 64 : n;
        f32x4 acc[8];
#pragma unroll
        for (int e = 0; e < 8; ++e) acc[e] = (f32x4){0.f, 0.f, 0.f, 0.f};
        for (int s = 0; s < s_end; s += 4) { const f32x4 w4 = *(const LAS f32x4*)(Wl + t * 132 + s);
#pragma unroll
            for (int q = 0; q < 4; ++q) { const float w = w4[q]; const LAS f32x4* vr = (const LAS f32x4*)(vn + (s + q) * 128 + cq * 32);
#pragma unroll
                for (int e = 0; e < 8; ++e) acc[e] += vr[e] * w; } }
        const float bias = bs[t]; const size_t row = (size_t)(row0 + t);
        const v4u* up = (const v4u*)(U + row * AW + h * 128 + cq * 32); v4u* op = (v4u*)(AO + row * D + h * 128 + cq * 32);
#pragma unroll
        for (int e2 = 0; e2 < 4; ++e2) { float uf[8]; unpack8(up[e2], uf); const f32x4 a0 = acc[2 * e2] + bias, a1 = acc[2 * e2 + 1] + bias;
            v4u w; w.x = cvt_pk_bf16(uf[0] * a0.x, uf[1] * a0.y); w.y = cvt_pk_bf16(uf[2] * a0.z, uf[3] * a0.w); w.z = cvt_pk_bf16(uf[4] * a1.x, uf[5] * a1.y); w.w = cvt_pk_bf16(uf[6] * a1.z, uf[7] * a1.w); op[e2] = w; } }
    __syncthreads();
}

__device__ __forceinline__ void attn_wave_task(const Args& a, int j, int task, const Ctx& c) {
    LAS float* kl = (LAS float*)(c.lds + c.wave * 8192);
    LAS float* vl = kl + 1024;
    const float* QF = (const float*)(wsp(a) + WS_QF); bf16* AO = (bf16*)(wsp(a) + WS_AO);
    int h, row0, pos0, b = 0; const bool smp = task >= 2048;
    if (!smp) { h = task & 15; const int qb = task >> 4; row0 = qb * 64; pos0 = row0; } else { const int s = task - 2048; h = s & 15; b = s >> 4; row0 = MP + b * 64; pos0 = 2048; }
    const int ipos = pos0 + c.lane;
    float q[64], o[64];
    { const f32x4* qp = (const f32x4*)(QF + (size_t)(row0 + c.lane) * 1024 + h * 64);
#pragma unroll
      for (int d4 = 0; d4 < 16; ++d4) { const f32x4 v = qp[d4]; q[4 * d4] = v.x * 0.125f; q[4 * d4 + 1] = v.y * 0.125f; q[4 * d4 + 2] = v.z * 0.125f; q[4 * d4 + 3] = v.w * 0.125f; } }
#pragma unroll
    for (int d = 0; d < 64; ++d) o[d] = 0.f;
    float R = 0.f;
    const float* kp_new = smp ? outp(a) + OFF_KS + (size_t)j * MS * 1024 + (size_t)(b * 64) * 1024 + h * 64 : outp(a) + OFF_KP + (size_t)j * MP * 1024 + h * 64;
    const float* vp_new = smp ? outp(a) + OFF_VS + (size_t)j * MS * 1024 + (size_t)(b * 64) * 1024 + h * 64 : outp(a) + OFF_VP + (size_t)j * MP * 1024 + h * 64;
    const float* kp_old = inp(a, I_CK) + ((size_t)j * 16 + b) * 2048 * 1024 + h * 64; const float* vp_old = inp(a, I_CV) + ((size_t)j * 16 + b) * 2048 * 1024 + h * 64;
    for (int jt = (pos0 + 64) / 16 - 1; jt >= 0; --jt) {
        const int kpos0 = jt * 16;
        const float* ksrc; const float* vsrc;
        if (smp && kpos0 < 2048) { ksrc = kp_old + (size_t)kpos0 * 1024; vsrc = vp_old + (size_t)kpos0 * 1024; }
        else { const int r = kpos0 - (smp ? 2048 : 0); ksrc = kp_new + (size_t)r * 1024; vsrc = vp_new + (size_t)r * 1024; }
#pragma unroll
        for (int k = 0; k < 4; ++k) { const int e = c.lane + 64 * k, key = e >> 4, d4 = e & 15;
            *(LAS f32x4*)(kl + key * 64 + d4 * 4) = *(const f32x4*)(ksrc + (size_t)key * 1024 + d4 * 4);
            *(LAS f32x4*)(vl + key * 64 + d4 * 4) = *(const f32x4*)(vsrc + (size_t)key * 1024 + d4 * 4); }
        LDS_WAIT(); asm volatile("" ::: "memory");
#pragma unroll 1
        for (int kk = 15; kk >= 0; --kk) {
            const LAS f32x4* kr = (const LAS f32x4*)(kl + kk * 64); float z0 = 0.f, z1 = 0.f, z2 = 0.f, z3 = 0.f;
#pragma unroll
            for (int hf = 0; hf < 2; ++hf) {
#pragma unroll
                for (int d4 = 8 * hf; d4 < 8 * hf + 8; ++d4) { const f32x4 kv = kr[d4]; z0 += q[4 * d4] * kv.x; z1 += q[4 * d4 + 1] * kv.y; z2 += q[4 * d4 + 2] * kv.z; z3 += q[4 * d4 + 3] * kv.w; }
                asm volatile("" ::: "memory"); }
            const float z = (z0 + z1) + (z2 + z3);
            const bool valid = (kpos0 + kk) < ipos;
            const float sp = fmaxf(z, 0.f) + __logf(1.f + __expf(-fabsf(z)));
            const float wgt = valid ? __expf(z - sp + R) : 0.f;
            R += valid ? -sp : 0.f;
            const LAS f32x4* vr = (const LAS f32x4*)(vl + kk * 64);
#pragma unroll
            for (int hf = 0; hf < 2; ++hf) {
#pragma unroll
                for (int d4 = 8 * hf; d4 < 8 * hf + 8; ++d4) { const f32x4 vv = vr[d4]; o[4 * d4] += wgt * vv.x; o[4 * d4 + 1] += wgt * vv.y; o[4 * d4 + 2] += wgt * vv.z; o[4 * d4 + 3] += wgt * vv.w; }
                asm volatile("" ::: "memory"); }
        }
        LDS_WAIT(); asm volatile("" ::: "memory");
        if (__all(R < -SB_THRESH)) break;
    }
    v4u* op = (v4u*)(AO + (size_t)(row0 + c.lane) * D + 1024 + h * 64);
#pragma unroll
    for (int d8 = 0; d8 < 8; ++d8) { v4u w; w.x = cvt_pk_bf16(o[8 * d8], o[8 * d8 + 1]); w.y = cvt_pk_bf16(o[8 * d8 + 2], o[8 * d8 + 3]); w.z = cvt_pk_bf16(o[8 * d8 + 4], o[8 * d8 + 5]); w.w = cvt_pk_bf16(o[8 * d8 + 6], o[8 * d8 + 7]); op[d8] = w; }
}
__device__ __forceinline__ void even_mix_phase(const Args& a, int j, const Ctx& c) {
    for (int task = blockIdx.x; task < 928; task += gridDim.x) {
        if (task < 512) spatial_task(a, j, (task >> 3) * 128, 128, task & 7, c);
        else if (task < 640) spatial_task(a, j, MP + ((task - 512) >> 3) * 64, 64, task & 7, c);
        else attn_wave_task(a, j, (task - 640) * 8 + c.wave, c);
    }
}

constexpr int SC_T = 32;
constexpr int SC_BUF = (5 * SC_T * 64 + 2 * SC_T * 16) * 4;
__device__ __forceinline__ void scan_load_chunk(const Args& a, int j, bool first, int row_base, int h, int rg, LAS float* buf, int lt) {
    const int s = lt >> 3, sub = lt & 7, c0 = sub * 8; const size_t off = (size_t)(row_base + s) * D + h * 64 + c0; const int ch = h * 64 + c0;
    float r[8], k[8], v[8], w[8], aa[8], kkp[8], kap[8];
    load8f((const float*)(wsp(a) + WS_R) + off, r); load8f((const float*)(wsp(a) + WS_K) + off, k); load8f((const float*)(wsp(a) + (first ? WS_V1 : WS_V3)) + off, v); load8f((const float*)(wsp(a) + WS_WD) + off, w);
    unpack8(*(const v4u*)((const bf16*)(wsp(a) + WS_AA) + off), aa);
    load8f(inp(a, I_KK) + (size_t)j * D + ch, kkp); load8f(inp(a, I_KA) + (size_t)j * D + ch, kap);
    if (!first) { float vf[8], vg[8]; load8f((const float*)(wsp(a) + WS_V1) + off, vf); unpack8(*(const v4u*)((const bf16*)(wsp(a) + WS_VG) + off), vg);
#pragma unroll
        for (int e = 0; e < 8; ++e) v[e] = v[e] + (vf[e] - v[e]) * vg[e]; }
    float kk[8], ss = 0.f;
#pragma unroll
    for (int e = 0; e < 8; ++e) { kk[e] = k[e] * kkp[e]; ss += kk[e] * kk[e]; }
    ss = reduce8(ss);
    const float inv = 1.f / fmaxf(sqrtf(ss), 1e-12f);
    LAS float* pr = buf + s * 64 + c0; LAS float* pw = pr + SC_T * 64; LAS float* pk = pw + SC_T * 64; LAS float* pa = pk + SC_T * 64; LAS float* pb = pa + SC_T * 64;
#pragma unroll
    for (int e = 0; e < 8; ++e) { const float kn = kk[e] * inv; pr[e] = r[e]; pw[e] = w[e]; pk[e] = k[e] * (1.f + (aa[e] - 1.f) * kap[e]); pa[e] = -kn; pb[e] = kn * aa[e]; }
    if ((sub >> 1) == rg) { LAS float* pv = buf + 5 * SC_T * 64 + s * 16 + (sub & 1) * 8;
#pragma unroll
        for (int e = 0; e < 8; ++e) pv[e] = v[e]; }
}
__device__ __forceinline__ void scan_store_y(const Args& a, int row_base, int h, int rg, const LAS float* buf, int lt) {
    const LAS float* yb = buf + 5 * SC_T * 64 + SC_T * 16; float* YS = (float*)(wsp(a) + WS_YS);
#pragma unroll
    for (int k = 0; k < 2; ++k) { const int idx = lt + 256 * k, s = idx >> 4, i = idx & 15; YS[(size_t)(row_base + s) * D + h * 64 + rg * 16 + i] = yb[s * 16 + i]; }
}
__device__ __forceinline__ void scan_phase(const Args& a, int j, const Ctx& c) {
    const bool first = (j == 0); const int G = gridDim.x, bid = blockIdx.x;
    constexpr int NPT = 128, NST = 2048;
    for (int it = 0;; ++it) {
        int task;
        if (G > NPT) { if (bid < NPT) { if (it > 0) break; task = bid; } else { task = NPT + (bid - NPT) + it * (G - NPT); if (task >= NPT + NST) break; } }
        else { task = bid + it * G; if (task >= NPT + NST) break; }
        int h, rg, row0, T; const float* s0 = nullptr; float* sout;
        if (task < NPT) { h = task >> 2; rg = task & 3; row0 = 0; T = MP; sout = outp(a) + OFF_WKVP + ((size_t)j * 32 + h) * 4096; }
        else { const int s = task - NPT, b = s >> 7; h = (s >> 2) & 31; rg = s & 3; row0 = MP + b * 64; T = 64; const size_t so = (((size_t)j * 16 + b) * 32 + h) * 4096; s0 = inp(a, I_WKV) + so; sout = outp(a) + OFF_WKVS + so; }
        const int nch = T / SC_T;
        LAS float* buf0 = (LAS float*)c.lds; LAS float* buf1 = (LAS float*)(c.lds + SC_BUF);
        const int jq = c.lane & 15, il = c.wave * 4 + (c.lane >> 4);
        f32x4 S = (f32x4){0.f, 0.f, 0.f, 0.f};
        if (c.wave < 4) { if (s0) S = *(const f32x4*)(s0 + (size_t)(rg * 16 + il) * 64 + 4 * jq); }
        else scan_load_chunk(a, j, first, row0, h, rg, buf0, c.tid - 256);
        __syncthreads();
        for (int ch = 0; ch < nch; ++ch) {
            LAS float* cur = (ch & 1) ? buf1 : buf0; LAS float* oth = (ch & 1) ? buf0 : buf1;
            if (c.wave < 4) {
                const LAS float* pr = cur + 4 * jq; LAS float* yb = cur + 5 * SC_T * 64 + SC_T * 16; const LAS float* pv = cur + 5 * SC_T * 64 + il;
#pragma unroll 4
                for (int t = 0; t < SC_T; ++t) {
                    const f32x4 r4 = *(const LAS f32x4*)(pr + t * 64), w4 = *(const LAS f32x4*)(pr + (SC_T + t) * 64), k4 = *(const LAS f32x4*)(pr + (2 * SC_T + t) * 64),
                                a4 = *(const LAS f32x4*)(pr + (3 * SC_T + t) * 64), b4 = *(const LAS f32x4*)(pr + (4 * SC_T + t) * 64);
                    const float vv = pv[t * 16];
                    const float sa = reduce16((S.x * a4.x + S.y * a4.y) + (S.z * a4.z + S.w * a4.w));
                    S = S * w4 + k4 * vv + b4 * sa;
                    const float y = reduce16((S.x * r4.x + S.y * r4.y) + (S.z * r4.z + S.w * r4.w));
                    if (jq == 0) yb[t * 16 + il] = y;
                }
            } else {
                const int lt = c.tid - 256;
                if (ch > 0) scan_store_y(a, row0 + (ch - 1) * SC_T, h, rg, oth, lt);
                if (ch + 1 < nch) { LDS_WAIT(); scan_load_chunk(a, j, first, row0 + (ch + 1) * SC_T, h, rg, oth, lt); }
            }
            __syncthreads();
        }
        if (c.wave >= 4) scan_store_y(a, row0 + (nch - 1) * SC_T, h, rg, ((nch - 1) & 1) ? buf1 : buf0, c.tid - 256);
        else *(f32x4*)(sout + (size_t)(rg * 16 + il) * 64 + 4 * jq) = S;
        __syncthreads();
    }
}

__device__ __forceinline__ void post_phase(const Args& a, int j, const Ctx& c) {
    const bool first = (j == 0);
    const float* YS = (const float*)(wsp(a) + WS_YS); const float* R = (const float*)(wsp(a) + WS_R); const float* K = (const float*)(wsp(a) + WS_K); const float* V = (const float*)(wsp(a) + (first ? WS_V1 : WS_V3));
    const float* VF = (const float*)(wsp(a) + WS_V1); const bf16* AA = (const bf16*)(wsp(a) + WS_AA); const bf16* VG = (const bf16*)(wsp(a) + WS_VG); const bf16* GG = (const bf16*)(wsp(a) + WS_GG); bf16* YG = (bf16*)(wsp(a) + WS_YG);
    const float* kap = inp(a, I_KA) + (size_t)j * D; const float* rkp = inp(a, I_RK) + (size_t)j * D; const float* gng = inp(a, I_GNG) + (size_t)j * D; const float* gnb = inp(a, I_GNB) + (size_t)j * D;
    const int g = c.lane >> 4, l16 = c.lane & 15;
    for (int wi = c.gw; wi < M * 32 / 4; wi += c.NGW) { const int item = wi * 4 + g, row = item >> 5, h = item & 31, ch = h * 64 + l16 * 4; const size_t off = (size_t)row * D + ch;
        const f32x4 y = *(const f32x4*)(YS + off), r = *(const f32x4*)(R + off), k = *(const f32x4*)(K + off); f32x4 v = *(const f32x4*)(V + off);
        const v2u aw = *(const v2u*)(AA + off), gw2 = *(const v2u*)(GG + off);
        const f32x4 aa = (f32x4){bf_lo(aw.x), bf_hi(aw.x), bf_lo(aw.y), bf_hi(aw.y)}, gg = (f32x4){bf_lo(gw2.x), bf_hi(gw2.x), bf_lo(gw2.y), bf_hi(gw2.y)};
        if (!first) { const f32x4 vf = *(const f32x4*)(VF + off); const v2u vw = *(const v2u*)(VG + off); const f32x4 vg = (f32x4){bf_lo(vw.x), bf_hi(vw.x), bf_lo(vw.y), bf_hi(vw.y)}; v = v + (vf - v) * vg; }
        const f32x4 ka4 = *(const f32x4*)(kap + ch), rk4 = *(const f32x4*)(rkp + ch), g4 = *(const f32x4*)(gng + ch), b4 = *(const f32x4*)(gnb + ch);
        const f32x4 k2 = k * ((aa - 1.f) * ka4 + 1.f);
        const float mean = reduce16((y.x + y.y) + (y.z + y.w)) * (1.f / 64.f); const f32x4 dy = y - mean;
        const float var = reduce16((dy.x * dy.x + dy.y * dy.y) + (dy.z * dy.z + dy.w * dy.w)) * (1.f / 64.f);
        const float rstd = 1.f / sqrtf(var + GN_EPS);
        const f32x4 rk = r * k2 * rk4; const float bonus = reduce16((rk.x + rk.y) + (rk.z + rk.w));
        const f32x4 o = (dy * rstd * g4 + b4 + v * bonus) * gg;
        *(v2u*)(YG + off) = pk4(o); }
}

constexpr int N_PHASES = 1 + 12 * 4;
__host__ __device__ constexpr bool phase_exists(int ph) { return ph == 0 || (ph < N_PHASES && !((((ph - 1) / 12) & 1) == 0 && ((ph - 1) % 12) >= 2 && ((ph - 1) % 12) <= 4)); }

__global__ void __launch_bounds__(NTHREADS, 2) fwd_kernel(Args args) {
    extern __shared__ __attribute__((aligned(16))) unsigned char lds_raw[];
    LAS unsigned char* lds = (LAS unsigned char*)lds_raw;
    const int G = gridDim.x;
    const int lo = args.ph_lo, hi = args.ph_hi; const bool fused = (hi - lo) > 1;
    if (threadIdx.x < 64) ((LAS unsigned*)(lds + LDSCTL_OFF))[threadIdx.x] = 0u;
    __syncthreads();
    XcdBarrier bar; bar.bar = (unsigned*)(wsp(args) + WS_CTL) + CW_BAR; bar.x = 0; bar.st = nullptr;
    if (fused) bar = xcd_barrier_post((unsigned*)(wsp(args) + WS_CTL) + CW_BAR, (volatile LAS unsigned*)(lds + LDSCTL_OFF));
#ifndef PHMASK
#define PHMASK 0xFFFFu
#endif
#define SEL(b) (((PHMASK) >> (b)) & 1u)
#define IN(k) (lo <= (k) && (k) < hi)
#define SEAM() do { if (fused) xcd_barrier(bar); } while (0)

    if (SEL(0) && IN(0)) { const Ctx c = make_ctx(lds); p0_prologue(args, c); SEAM(); }

    for (int L = 0; L < 4; ++L) {
        const int base = 1 + 12 * L, j = L >> 1;
#define ws wsp(args)
#define X ((float*)(wsp(args) + WS_X))
#define XB ((bf16*)(wsp(args) + WS_XB + (size_t)(L & 1) * SZ_X16))
#define XBN ((bf16*)(wsp(args) + WS_XB + (size_t)((L + 1) & 1) * SZ_X16))
#define Y ((float*)(wsp(args) + WS_Y))
        if ((L & 1) == 0) {
            if (SEL(1) && IN(base + 0)) {
                pg8::Gemm g{XB, (const bf16*)(ws + WS_WIN + j * SZ_WIN), M, EVEN_IN, D, D, 0ull, 0ull, 0};
                pg8::StaticOrder S; S.init(M, EVEN_IN, G, (int)blockIdx.x);
                EpiEvenIn E{(bf16*)(ws + WS_U), (bf16*)(ws + WS_ZV), (float*)(ws + WS_QF), outp(args), j};
                pg8::gemm_phase<EpiEvenIn, pg8::StaticOrder, true>(lds, g, S, E);
                SEAM();
            }
            if (SEL(2) && IN(base + 1)) { const Ctx c = make_ctx(lds); even_mix_phase(args, j, c); SEAM(); }
            if (SEL(3) && IN(base + 5)) {
                pg8::Gemm g{(const bf16*)(ws + WS_AO), (const bf16*)(ws + WS_WOE + j * SZ_W22), M, D, D, D, 0ull, 0ull, 0};
                pg8::StaticOrder S; S.init(M, D, G, (int)blockIdx.x);
                EpiResid E{X, Y};
                pg8::gemm_phase<EpiResid, pg8::StaticOrder, true>(lds, g, S, E);
                SEAM();
            }
        } else {
            if (SEL(4) && IN(base + 0)) { const Ctx c = make_ctx(lds); mix_phase(args, j, c); SEAM(); }
            if (SEL(5) && IN(base + 1)) {
                pg8::Gemm g{(const bf16*)(ws + WS_MIX), (const bf16*)(ws + WS_W1T + j * SZ_W1T), M, N_O1, D, D, 0x2222222200000000ull, 0x0000534133333333ull, (size_t)M * D};
                pg8::StaticOrder S; S.init(M, N_O1, G, (int)blockIdx.x);
                EpiO1 E{(float*)(ws + WS_R), (float*)(ws + WS_K), (float*)(ws + (j == 0 ? WS_V1 : WS_V3)), (bf16*)(ws + WS_H1)};
                pg8::gemm_phase<EpiO1, pg8::StaticOrder, true>(lds, g, S, E);
                SEAM();
            }
            if (SEL(6) && IN(base + 2)) {
                pg8::Gemm g{(const bf16*)(ws + WS_H1), (const bf16*)(ws + WS_W2T + j * SZ_W2T), M, N_O2, 256, 512, 0ull, 0x1111111100000000ull, 256};
                pg8::StaticOrder S; S.init(M, N_O2, G, (int)blockIdx.x);
                EpiO2 E{(float*)(ws + WS_WD), (bf16*)(ws + WS_AA), (bf16*)(ws + WS_VG), (bf16*)(ws + WS_GG), inp(args, I_W0) + (size_t)j * D, inp(args, I_A0) + (size_t)j * D, j == 0 ? nullptr : inp(args, I_V0)};
                pg8::gemm_phase<EpiO2, pg8::StaticOrder, true>(lds, g, S, E);
                SEAM();
            }
            if (SEL(7) && IN(base + 3)) { const Ctx c = make_ctx(lds); scan_phase(args, j, c); SEAM(); }
            if (SEL(8) && IN(base + 4)) { const Ctx c = make_ctx(lds); post_phase(args, j, c); SEAM(); }
            if (SEL(9) && IN(base + 5)) {
                pg8::Gemm g{(const bf16*)(ws + WS_YG), (const bf16*)(ws + WS_WOC + j * SZ_W22), M, D, D, D, 0ull, 0ull, 0};
                pg8::StaticOrder S; S.init(M, D, G, (int)blockIdx.x);
                EpiResid E{X, Y};
                pg8::gemm_phase<EpiResid, pg8::StaticOrder, true>(lds, g, S, E);
                SEAM();
            }
        }
        if (SEL(10) && IN(base + 6)) { const Ctx c = make_ctx(lds); ln_phase(Y, inp(args, I_LN1G) + (size_t)L * D, inp(args, I_LN1B) + (size_t)L * D, X, XB, c); SEAM(); }
        if (SEL(11) && IN(base + 7)) {
            pg8::Gemm g{XB, (const bf16*)(ws + WS_FIN + L * SZ_FIN), M, 2 * DFF, D, D, 0ull, 0ull, 0};
            pg8::StaticOrder S; S.init(M, 2 * DFF, G, (int)blockIdx.x);
            EpiFfnIn E{(bf16*)(ws + WS_HG), (bf16*)(ws + WS_HU), outp(args), L};
            pg8::gemm_phase<EpiFfnIn, pg8::StaticOrder, true>(lds, g, S, E);
            SEAM();
        }
        if (SEL(12) && IN(base + 8)) {
            { const Ctx c = make_ctx(lds); act_phase(args, L, c); }
            __syncthreads();
            pg8::Gemm g{(const bf16*)(ws + WS_PB + L * SZ_PB), (const bf16*)(ws + WS_WP + L * SZ_WP), M, D, PLE, PLE, 0ull, 0ull, 0};
            pg8::StaticOrder S; S.init(M, D, G, (int)blockIdx.x);
            EpiF32 E{(float*)(ws + WS_PPF), D};
            pg8::gemm_phase<EpiF32, pg8::StaticOrder, true>(lds, g, S, E);
            SEAM();
        }
        if (SEL(13) && IN(base + 9)) {
            pg8::Gemm g{(const bf16*)(ws + WS_ACT), (const bf16*)(ws + WS_FOUT + L * SZ_FOUT), M, D, DFF, DFF, 0ull, 0ull, 0};
            pg8::StaticOrder S; S.init(M, D, G, (int)blockIdx.x);
            EpiResid E{X, Y};
            pg8::gemm_phase<EpiResid, pg8::StaticOrder, true>(lds, g, S, E);
            SEAM();
        }
        if (SEL(14) && IN(base + 10)) { const Ctx c = make_ctx(lds); ln_phase(Y, inp(args, I_LN2G) + (size_t)L * D, inp(args, I_LN2B) + (size_t)L * D, X, XB, c); SEAM(); }
        if (SEL(15) && IN(base + 11)) {
            pg8::Gemm g{XB, (const bf16*)(ws + WS_WG + L * SZ_W22), M, D, D, D, 0ull, 0ull, 0};
            pg8::StaticOrder S; S.init(M, D, G, (int)blockIdx.x);
            EpiPle E{X, XBN, (const float*)(ws + WS_PPF), L == 3 ? outp(args) : nullptr};
            pg8::gemm_phase<EpiPle, pg8::StaticOrder, true>(lds, g, S, E);
            SEAM();
        }
    }
#undef IN
#undef SEAM
#undef ws
#undef X
#undef XB
#undef XBN
#undef Y
}

extern "C" void kernel_launch(void* const* d_in, const int* in_sizes, int n_in, void* d_out, int out_size, void* d_ws, size_t ws_size, hipStream_t stream) {
    static int grid = 0;
    if (grid == 0) {
        if (n_in != N_IN || out_size != (int)OUT_END || ws_size < WS_END) { fprintf(stderr, "kernel_launch: unexpected problem shape (n_in %d, out %d, ws %zu; need %d, %zu, %zu)\n", n_in, out_size, ws_size, (int)N_IN, (size_t)OUT_END, (size_t)WS_END); grid = -1; return; }
        int dev = 0, cus = 0, per_cu = 0;
        if (hipGetDevice(&dev) != hipSuccess || hipDeviceGetAttribute(&cus, hipDeviceAttributeMultiprocessorCount, dev) != hipSuccess) { grid = -1; return; }
        if (hipFuncSetAttribute((const void*)fwd_kernel, hipFuncAttributeMaxDynamicSharedMemorySize, LDS_BYTES) != hipSuccess) { fprintf(stderr, "kernel_launch: hipFuncSetAttribute failed\n"); grid = -1; return; }
        if (hipOccupancyMaxActiveBlocksPerMultiprocessor(&per_cu, (const void*)fwd_kernel, NTHREADS, LDS_BYTES) != hipSuccess || per_cu < 1) fprintf(stderr, "kernel_launch: occupancy query reports %d\n", per_cu);
        (void)hipGetLastError();
        grid = cus;
    }
    if (grid < 0) return;
    (void)in_sizes;
    if (hipMemsetAsync((char*)d_ws + WS_CTL, 0, CTL_ZERO_BYTES, stream) != hipSuccess) return;
    Args a{};
    for (int i = 0; i < N_IN; ++i) a.in[i] = (const float*)d_in[i];
    a.out = (float*)d_out; a.ws = (unsigned char*)d_ws;
#if MK_ONE_LAUNCH
    a.ph_lo = 0; a.ph_hi = N_PHASES;
    hipLaunchKernelGGL(fwd_kernel, dim3(grid), dim3(NTHREADS), LDS_BYTES, stream, a);
#else
    for (int ph = 0; ph < N_PHASES; ++ph) { if (!phase_exists(ph)) continue; a.ph_lo = ph; a.ph_hi = ph + 1;
        hipLaunchKernelGGL(fwd_kernel, dim3(grid), dim3(NTHREADS), LDS_BYTES, stream, a); }
#endif
}
```

```cpp
#include <hip/hip_runtime.h>
#include <cstdio>
#include <cstdint>

#ifndef MK_ONE_LAUNCH
#define MK_ONE_LAUNCH 1
#endif

namespace pg8 {
#define PG8_LAS __attribute__((address_space(3)))
typedef unsigned short bf16_t;
typedef short bf16x8 __attribute__((ext_vector_type(8)));
typedef float f32x4 __attribute__((ext_vector_type(4)));
typedef unsigned u32x4 __attribute__((ext_vector_type(4)));
typedef unsigned u32x2 __attribute__((ext_vector_type(2)));
constexpr int BM = 256, BK = 64, HALF = 128, HTB = HALF * BK * 2  , STAGE_BYTES = 8 * HTB, NXCD = 8, WGM = 8;

__host__ __device__ __forceinline__ int lds_byte(int r, int c) { const int st = (r >> 4) * 2 + (c >> 5), rr = r & 15, cc = c & 31, ob = rr * 64 + cc * 2; return st * 1024 + (ob ^ (((ob >> 9) & 1) << 5)); }
__host__ __device__ __forceinline__ void stage_rc(int b, int& R, int& C) { const int st = b / 1024, sb = b % 1024, swz = sb ^ (((sb >> 9) & 1) << 5); R = (st >> 1) * 16 + swz / 64; C = (st & 1) * 32 + (swz % 64) / 2; }
__host__ __device__ __forceinline__ int perm32(int rho) { const int n = rho >> 4, i = rho & 15; return 8 * (i >> 2) + 4 * n + (i & 3); }

struct Unit { int pm, pn, k0, nt, sp; };
struct Gemm { const bf16_t* A; const bf16_t* Bt; int M, N, K, lda; unsigned long long asel0, asel1; size_t asel_stride; };
__device__ __forceinline__ const char* a_base(const Gemm& g, const Unit& u) {
    size_t off = 0;
    if (g.asel_stride) { const unsigned sel = (unsigned)(((u.pn < 16) ? (g.asel0 >> (4 * u.pn)) : (g.asel1 >> (4 * (u.pn & 15)))) & 15ull); off = (size_t)sel * g.asel_stride; }
    return (const char*)(g.A + off) + (size_t)u.pm * ((size_t)BM * g.lda * 2) + (size_t)u.k0 * 2;
}

__host__ __device__ __forceinline__ void tile_of(int wgid, int nM, int nN, Unit& u) {
    const int nwg = nM * nN; { const int q = nwg / NXCD, r = nwg % NXCD, xcd = wgid % NXCD, off = wgid / NXCD; wgid = (xcd < r ? xcd * (q + 1) : r * (q + 1) + (xcd - r) * q) + off; }
    const int nig = WGM * nN, gid = wgid / nig, fm = gid * WGM, gsz = (nM - fm) < WGM ? (nM - fm) : WGM;
    u.pm = fm + ((wgid % nig) % gsz); u.pn = (wgid % nig) / gsz; u.k0 = 0; u.nt = -1; u.sp = 0;
}
struct StaticOrder {
    int nM, nN, nwg, G, c;
    __host__ __device__ void init(int M, int N, int G_, int c_) { nM = M / BM; nN = N / BM; nwg = nM * nN; G = G_; c = c_; }
    __host__ __device__ bool next(int i, Unit& u) const { const long L = (long)i * G + c; if (L >= nwg) return false; tile_of((int)L, nM, nN, u); return true; }
    __device__ __forceinline__ void a_ready(const Unit&) const {}
    __device__ __forceinline__ void done(const Unit&) const {}
};
struct SplitOrder {
    int G, c, nchunk;
    __host__ __device__ void init(int K, int G_, int c_) { G = G_; c = c_; nchunk = K / 128; }
    __host__ __device__ bool next(int i, Unit& u) const {
        const long L = (long)i * G + c;
        if (L < 256) { tile_of((int)L, 32, 8, u); return true; }
        const int v = (int)(L - 256); if (v >= 256) return false;
        const int tile = v & 31, s = v >> 5, c0 = (nchunk * s) >> 3, c1 = (nchunk * (s + 1)) >> 3;
        u.pm = 32 + (tile >> 3); u.pn = tile & 7; u.k0 = c0 * 128; u.nt = (c1 - c0) * 2; u.sp = s; return true;
    }
    __device__ __forceinline__ void a_ready(const Unit&) const {}
    __device__ __forceinline__ void done(const Unit&) const {}
};

__device__ __forceinline__ unsigned cvt_pk_bf16(float lo, float hi) { unsigned r; asm volatile("v_cvt_pk_bf16_f32 %0, %1, %2" : "=v"(r) : "v"(lo), "v"(hi)); return r; }

template <class Epi, class Sched, bool ALIGN_EPI = false>
__device__ __forceinline__ void gemm_phase(PG8_LAS unsigned char* lds, const Gemm g, const Sched& S, const Epi& E) {
    int tid_ = threadIdx.x; asm volatile("" : "+v"(tid_));
    const int tid = tid_, wid = __builtin_amdgcn_readfirstlane(tid >> 6), lane = tid & 63, wr = wid >> 2, wc = wid & 3, fr = lane & 15, fq = lane >> 4;
    const int K = g.K, nt = K / BK, lda = g.lda;
    unsigned voffA[2], voffB[2];
#pragma unroll
    for (int i = 0; i < 2; ++i) { int R, C; stage_rc(tid * 16 + i * 8192, R, C); const int Rb = Epi::PERM ? ((R & ~31) + perm32(R & 31)) : R;
        voffA[i] = (unsigned)(R * lda + C) * 2u; voffB[i] = (unsigned)(Rb * K + C) * 2u; }
    const size_t kstep = (size_t)(BK * 2);
    const size_t hstepA = (size_t)HALF * lda * 2, hstepB = (size_t)HALF * K * 2;
    const size_t tstepB = 2 * hstepB;
    const unsigned ldsw = (unsigned)wid * 1024u;
    const int aoff = lds_byte(wr * 64 + fr, fq * 8), boff = lds_byte(wc * 32 + fr, fq * 8);
#define PG8_SA(b, h) (((b) * 2 + (h)) * HTB)
#define PG8_SB(b, h) ((4 + (b) * 2 + (h)) * HTB)
#define PG8_STAGE(bufoff, gbase, voff) do { _Pragma("unroll") for (int _i = 0; _i < 2; ++_i) \
        __builtin_amdgcn_global_load_lds((const unsigned*)((const char*)(gbase) + (voff)[_i]), (PG8_LAS unsigned*)(lds + (bufoff) + ldsw + _i * 8192), 16, 0, 0); } while (0)
#define PG8_LDA(dst, b, h) do { _Pragma("unroll") for (int m = 0; m < 4; ++m) _Pragma("unroll") for (int k = 0; k < 2; ++k) dst[m][k] = *(const PG8_LAS bf16x8*)(lds + PG8_SA(b, h) + aoff + m * 2048 + k * 1024); } while (0)
#define PG8_LDB(dst, b, h) do { _Pragma("unroll") for (int n = 0; n < 2; ++n) _Pragma("unroll") for (int k = 0; k < 2; ++k) dst[n][k] = *(const PG8_LAS bf16x8*)(lds + PG8_SB(b, h) + boff + n * 2048 + k * 1024); } while (0)
#define PG8_MMA(ai, bj, At, Bt) do { __builtin_amdgcn_s_setprio(1); _Pragma("unroll") for (int m = 0; m < 4; ++m) _Pragma("unroll") for (int n = 0; n < 2; ++n) _Pragma("unroll") for (int k = 0; k < 2; ++k) \
        acc[ai][bj][m][n] = __builtin_amdgcn_mfma_f32_16x16x32_bf16(Bt[n][k], At[m][k], acc[ai][bj][m][n], 0, 0, 0); __builtin_amdgcn_s_setprio(0); } while (0)
#define PG8_WAIT_V(n) asm volatile("s_waitcnt vmcnt(" #n ")" ::: "memory")
#define PG8_WAIT_L(n) asm volatile("s_waitcnt lgkmcnt(" #n ")" ::: "memory")
#define PG8_BAR __builtin_amdgcn_s_barrier()
#define PG8_SCHED __builtin_amdgcn_sched_barrier(0)
    Unit cur, nxt; int ui = 0;
    if (!S.next(0, cur)) return;
    f32x4 acc[2][2][4][2];
#pragma unroll
    for (int a = 0; a < 2; ++a)
#pragma unroll
        for (int b = 0; b < 2; ++b)
#pragma unroll
            for (int m = 0; m < 4; ++m)
#pragma unroll
                for (int n = 0; n < 2; ++n) acc[a][b][m][n] = (f32x4){0.f, 0.f, 0.f, 0.f};
    bf16x8 At[4][2], B0[2][2], B1[2][2];
    const char* cA = a_base(g, cur); const char* cB = (const char*)g.Bt + (size_t)cur.pn * tstepB + (size_t)cur.k0 * 2;
    S.a_ready(cur);
    PG8_STAGE(PG8_SB(0, 0), cB, voffB); PG8_STAGE(PG8_SB(0, 1), cB + hstepB, voffB); PG8_STAGE(PG8_SA(0, 0), cA, voffA); PG8_STAGE(PG8_SA(0, 1), cA + hstepA, voffA);
    if (wr == 1) PG8_BAR;
    PG8_WAIT_V(2); PG8_BAR;
    PG8_STAGE(PG8_SB(1, 0), cB + kstep, voffB); PG8_STAGE(PG8_SA(1, 0), cA + kstep, voffA); PG8_STAGE(PG8_SB(1, 1), cB + hstepB + kstep, voffB);
    PG8_WAIT_V(6); PG8_BAR;
    for (;;) {
        const bool has_next = S.next(ui + 1, nxt);
        const char* nA = has_next ? a_base(g, nxt) : cA; const char* nB = has_next ? (const char*)g.Bt + (size_t)nxt.pn * tstepB + (size_t)nxt.k0 * 2 : cB;
        const int unt = cur.nt < 0 ? nt : cur.nt;
#pragma unroll 1
        for (int t = 0; t < unt; t += 2) {
            const bool last = (t == unt - 2);
            const char* a1 = cA + (size_t)(t + 1) * kstep;
            const char* a2 = last ? nA : cA + (size_t)(t + 2) * kstep; const char* b2 = last ? nB : cB + (size_t)(t + 2) * kstep;
            const char* a3 = a2 + kstep; const char* b3 = b2 + kstep;
            if (last && has_next) S.a_ready(nxt);
            PG8_LDB(B0, 0, 0); PG8_LDB(B1, 0, 1); PG8_SCHED; PG8_LDA(At, 0, 0); PG8_STAGE(PG8_SA(1, 1), a1 + hstepA, voffA);
            PG8_WAIT_V(8); PG8_WAIT_L(0); PG8_BAR; PG8_MMA(0, 0, At, B0); PG8_MMA(0, 1, At, B1); PG8_BAR; PG8_SCHED;
            PG8_LDA(At, 0, 1); PG8_STAGE(PG8_SB(0, 0), b2, voffB); PG8_STAGE(PG8_SB(0, 1), b2 + hstepB, voffB); PG8_STAGE(PG8_SA(0, 0), a2, voffA);
            PG8_WAIT_V(8); PG8_WAIT_L(0); PG8_BAR; PG8_MMA(1, 0, At, B0); PG8_MMA(1, 1, At, B1); PG8_BAR; PG8_SCHED;
            PG8_LDB(B0, 1, 0); PG8_LDB(B1, 1, 1); PG8_SCHED; PG8_LDA(At, 1, 0); PG8_STAGE(PG8_SA(0, 1), a2 + hstepA, voffA);
            PG8_WAIT_V(8); PG8_WAIT_L(0); PG8_BAR; PG8_MMA(0, 0, At, B0); PG8_MMA(0, 1, At, B1); PG8_BAR; PG8_SCHED;
            PG8_LDA(At, 1, 1); PG8_STAGE(PG8_SB(1, 0), b3, voffB); PG8_STAGE(PG8_SB(1, 1), b3 + hstepB, voffB); PG8_STAGE(PG8_SA(1, 0), a3, voffA);
            PG8_WAIT_V(8); PG8_WAIT_L(0); PG8_BAR; PG8_MMA(1, 0, At, B0); PG8_MMA(1, 1, At, B1); PG8_BAR; PG8_SCHED;
        }
        if constexpr (ALIGN_EPI) { if (wr == 0) PG8_BAR; }
        E(acc, cur, wr, wc, fr, fq); S.done(cur);
        if (!has_next) break;
#pragma unroll
        for (int a = 0; a < 2; ++a)
#pragma unroll
            for (int b = 0; b < 2; ++b)
#pragma unroll
                for (int m = 0; m < 4; ++m)
#pragma unroll
                    for (int n = 0; n < 2; ++n) acc[a][b][m][n] = (f32x4){0.f, 0.f, 0.f, 0.f};
        cur = nxt; cA = nA; cB = nB; ++ui;
        if constexpr (ALIGN_EPI) { if (wr == 1) PG8_BAR; }
    }
    PG8_WAIT_V(0);
    if constexpr (!ALIGN_EPI) { if (wr == 0) PG8_BAR; }
    PG8_BAR;
#undef PG8_SA
#undef PG8_SB
#undef PG8_STAGE
#undef PG8_LDA
#undef PG8_LDB
#undef PG8_MMA
#undef PG8_WAIT_V
#undef PG8_WAIT_L
#undef PG8_BAR
#undef PG8_SCHED
}
}

constexpr int NWAVES = 8, NTHREADS = 512;
constexpr int D = 2048, MP = 8192, MS = 1024, M = MP + MS;
constexpr int AW = 1024, EVEN_IN = 5120, DFF = 5632, PLE = 256;
constexpr int N_O1 = 7168, N_O2 = 8192;
constexpr float ALPHA = 1.6817928305074292f;
constexpr float LN_EPS = 1e-5f, GN_EPS = 64e-5f;
constexpr float SB_THRESH = 100.0f;

constexpr size_t OFF_YP = 0, OFF_YS = 16777216, OFF_KP = 18874368, OFF_VP = 35651584, OFF_WKVP = 52428800, OFF_SHP = 52690944, OFF_CVP = 52695040,
                 OFF_KS = 52740096, OFF_VS = 54837248, OFF_VAS = 56934400, OFF_WKVS = 59031552, OFF_SHS = 63225856, OFF_CVS = 63291392, OUT_END = 64012288;

enum { I_XP = 0, I_XS, I_CK, I_CV, I_WKV, I_SHIFT, I_CONV, I_PP, I_PS, I_EWIN, I_LNVG, I_LNVB, I_EWS, I_EBS, I_EWO, I_MU, I_CWR, I_CWK, I_CWV, I_CWO, I_W0, I_W1, I_W2,
       I_A0, I_A1, I_A2, I_V0, I_V1, I_V2, I_G1, I_G2, I_KK, I_KA, I_RK, I_GNG, I_GNB, I_FWIN, I_FCW, I_FCB, I_FWOUT, I_LN1G, I_LN1B, I_LN2G, I_LN2B, I_PLEP, I_PLEG, N_IN };

constexpr size_t MiB = 1u << 20;
constexpr size_t WS_CTL = 0, CTL_ZERO_BYTES = 1 * MiB;
constexpr size_t SZ_WIN = 5120ull * 2048 * 2, SZ_W22 = 2048ull * 2048 * 2, SZ_W1T = 7168ull * 2048 * 2, SZ_W2T = 8192ull * 256 * 2, SZ_FIN = 11264ull * 2048 * 2, SZ_FOUT = 2048ull * 5632 * 2, SZ_WP = 2048ull * 256 * 2;
constexpr size_t WS_WIN = 1 * MiB, WS_WOE = WS_WIN + 2 * SZ_WIN, WS_W1T = WS_WOE + 2 * SZ_W22, WS_W2T = WS_W1T + 2 * SZ_W1T, WS_WOC = WS_W2T + 2 * SZ_W2T,
                 WS_FIN = WS_WOC + 2 * SZ_W22, WS_FOUT = WS_FIN + 4 * SZ_FIN, WS_WG = WS_FOUT + 4 * SZ_FOUT, WS_WP = WS_WG + 4 * SZ_W22, WS_WEND = WS_WP + 4 * SZ_WP;
constexpr size_t SZ_X32 = (size_t)M * D * 4, SZ_X16 = (size_t)M * D * 2, SZ_PB = (size_t)M * PLE * 2, SZ_H16 = (size_t)M * 1024 * 2, SZ_FF16 = (size_t)M * DFF * 2, SZ_H1 = (size_t)M * 512 * 2;
constexpr size_t WS_X = WS_WEND, WS_XB = WS_X + SZ_X32, WS_Y = WS_XB + 2 * SZ_X16,
                 WS_PB = WS_Y + SZ_X32, WS_V1 = WS_PB + 4 * SZ_PB, WS_SCR = WS_V1 + SZ_X32;
constexpr size_t WS_U = WS_SCR, WS_ZV = WS_U + SZ_H16, WS_QF = WS_ZV + SZ_H16, WS_AO = WS_QF + 2 * SZ_H16, WS_EVEN_END = WS_AO + SZ_X16;
constexpr size_t WS_MIX = WS_SCR, WS_R = WS_MIX + 6 * SZ_X16, WS_K = WS_R + SZ_X32, WS_V3 = WS_K + SZ_X32, WS_H1 = WS_V3 + SZ_X32, WS_WD = WS_H1 + SZ_H1, WS_AA = WS_WD + SZ_X32,
                 WS_VG = WS_AA + SZ_X16, WS_GG = WS_VG + SZ_X16, WS_ODD_END = WS_GG + SZ_X16, WS_YS = WS_MIX, WS_YG = WS_MIX + SZ_X32;
constexpr size_t SZ_SLAB = (size_t)MS * D * 4, WS_SLAB = WS_ODD_END;
constexpr size_t WS_HG = WS_SCR, WS_HU = WS_HG + SZ_FF16, WS_ACT = WS_HU + SZ_FF16, WS_PPF = WS_ACT + SZ_FF16, WS_FFN_END = WS_PPF + SZ_X32;
constexpr size_t WS_END = WS_SLAB + 7 * SZ_SLAB;
static_assert(WS_FFN_END <= WS_SLAB && WS_EVEN_END <= WS_SLAB, "overlays below the slabs");
static_assert(WS_END <= 1568358400ull, "workspace map exceeds the guaranteed d_ws size");
constexpr int CW_BAR = 4096;

constexpr int LDS_BYTES = 147456;
constexpr int LDSCTL_OFF = LDS_BYTES - 256;

#define GAS __attribute__((address_space(1)))
#define LAS __attribute__((address_space(3)))
typedef unsigned short bf16;
typedef unsigned v4u __attribute__((ext_vector_type(4)));
typedef unsigned v2u __attribute__((ext_vector_type(2)));
typedef float f32x4 __attribute__((ext_vector_type(4)));
typedef float f32x2 __attribute__((ext_vector_type(2)));
#define LDS_WAIT() asm volatile("s_waitcnt lgkmcnt(0)" ::: "memory")
#define VM_WAIT() asm volatile("s_waitcnt vmcnt(0)" ::: "memory")
using pg8::cvt_pk_bf16;
__device__ __forceinline__ float bf_lo(unsigned w) { return __uint_as_float(w << 16); }
__device__ __forceinline__ float bf_hi(unsigned w) { return __uint_as_float(w & 0xffff0000u); }
__device__ __forceinline__ float sigmoid_f(float x) { return 1.f / (1.f + __expf(-x)); }
__device__ __forceinline__ float tanh_f(float x) { return 1.f - 2.f / (1.f + __expf(2.f * x)); }
__device__ __forceinline__ float gelu_f(float x) { const float u = 0.7978845608028654f * (x + 0.044715f * x * x * x); return x / (1.f + __expf(-2.f * u)); }
__device__ __forceinline__ f32x4 gelu4(f32x4 v) { return (f32x4){gelu_f(v.x), gelu_f(v.y), gelu_f(v.z), gelu_f(v.w)}; }
__device__ __forceinline__ v2u pk4(f32x4 v) { v2u r; r.x = cvt_pk_bf16(v.x, v.y); r.y = cvt_pk_bf16(v.z, v.w); return r; }
__device__ __forceinline__ float fma_s(float a, float b, float c) { float r; asm("v_fma_f32 %0, %1, %2, %3" : "=v"(r) : "v"(a), "v"(b), "v"(c)); return r; }
__device__ __forceinline__ float mul_s(float a, float b) { float r; asm("v_mul_f32_e32 %0, %1, %2" : "=v"(r) : "v"(a), "v"(b)); return r; }
template <int CTRL> __device__ __forceinline__ float dpp_f(float x) { return __builtin_bit_cast(float, __builtin_amdgcn_update_dpp(0, __builtin_bit_cast(int, x), CTRL, 0xF, 0xF, true)); }
__device__ __forceinline__ float reduce8(float x) { x += dpp_f<0xB1>(x); x += dpp_f<0x4E>(x); x += dpp_f<0x141>(x); return x; }
__device__ __forceinline__ float reduce16(float x) { x = reduce8(x); x += dpp_f<0x140>(x); return x; }
__device__ __forceinline__ float wave_sum(float x) { x = reduce16(x); x += __shfl_xor(x, 16); x += __shfl_xor(x, 32); return x; }

#define XLAS LAS
#define XB_TMO      128
#define XB_XCNT(j)  (256  + 64 * (j))
#define XB_XSUB(j)  (1280 + 64 * (j))
#define XB_XGEN(j)  (2304 + 64 * (j))
#define XB_TOP      3328
#define XB_TOPGEN   3392
#define XCD_BAR_WORDS 3456
#define XB_SPIN_CAP (1u << 18)
__device__ __forceinline__ unsigned xb_ld(unsigned* p)              { return __hip_atomic_load(p, __ATOMIC_RELAXED, __HIP_MEMORY_SCOPE_AGENT); }
__device__ __forceinline__ unsigned xb_add(unsigned* p, unsigned v) { return __hip_atomic_fetch_add(p, v, __ATOMIC_RELAXED, __HIP_MEMORY_SCOPE_AGENT); }
__device__ __forceinline__ unsigned xb_xcc_id() { return (unsigned)__builtin_amdgcn_s_getreg((3 << 11) | 20) & 0xFu; }
#define XB_SPIN(cond, bar) do { unsigned _sp = 0; while (cond) { __builtin_amdgcn_s_sleep(1); \
    if ((++_sp & 255u) == 0u) { if (xb_ld(&(bar)[XB_TMO])) break; if (_sp > XB_SPIN_CAP) { atomicAdd(&(bar)[XB_TMO], 1u); break; } } } } while (0)
struct XcdBarrier { unsigned* bar; unsigned x; volatile LAS unsigned* st; };
__device__ __forceinline__ XcdBarrier xcd_barrier_post(unsigned* bar, volatile LAS unsigned* st) {
    XcdBarrier b; b.bar = bar; b.x = xb_xcc_id(); b.st = st;
    if (threadIdx.x == 0) (void)xb_add(&bar[XB_XCNT(b.x)], 1u);
    return b;
}
__device__ __forceinline__ void xcd_barrier_complete(unsigned* bar, unsigned x, unsigned& nloc, unsigned& nx) {
    const unsigned G = gridDim.x * gridDim.y * gridDim.z;
    unsigned sum, cnt, mine, sp = 0u;
    for (;;) {
        sum = 0u; cnt = 0u; mine = 0u;
#pragma unroll
        for (unsigned j = 0; j < 16; ++j) { const unsigned c = xb_ld(&bar[XB_XCNT(j)]); sum += c; cnt += (c > 0u) ? 1u : 0u; mine = (j == x) ? c : mine; }
        if (sum == G) break;
        __builtin_amdgcn_s_sleep(1);
        if ((++sp & 255u) == 0u) { if (xb_ld(&bar[XB_TMO])) break; if (sp > XB_SPIN_CAP) { atomicAdd(&bar[XB_TMO], 1u); break; } }
    }
    nloc = mine > 0u ? mine : 1u; nx = cnt > 0u ? cnt : 1u;
}
__device__ __forceinline__ void xcd_barrier(const XcdBarrier& b) {
    asm volatile("s_waitcnt vmcnt(0)" ::: "memory");
    __syncthreads();
    if (threadIdx.x == 0) {
        unsigned* bar = b.bar;
        __builtin_amdgcn_s_waitcnt(0);
        unsigned nloc = b.st[0], nx = b.st[1];
        if (nloc == 0u) { xcd_barrier_complete(bar, b.x, nloc, nx); b.st[0] = nloc; b.st[1] = nx; }
        const unsigned old = xb_add(&bar[XB_XSUB(b.x)], 1u);
        const unsigned gen = old / nloc;
        if (old + 1u == (gen + 1u) * nloc) {
            __builtin_amdgcn_fence(__ATOMIC_RELEASE, "agent");
            asm volatile("s_waitcnt vmcnt(0)" ::: "memory");
            const unsigned og = xb_add(&bar[XB_TOP], 1u);
            const unsigned tg = og / nx;
            if (og + 1u == (tg + 1u) * nx) xb_add(&bar[XB_TOPGEN], 1u);
            else XB_SPIN(xb_ld(&bar[XB_TOPGEN]) == tg, bar);
            __builtin_amdgcn_fence(__ATOMIC_ACQUIRE, "agent");
            xb_add(&bar[XB_XGEN(b.x)], 1u);
            asm volatile("s_waitcnt vmcnt(0)" ::: "memory");
        } else {
            XB_SPIN(xb_ld(&bar[XB_XGEN(b.x)]) == gen, bar);
            __builtin_amdgcn_fence(__ATOMIC_ACQUIRE, "agent");
            asm volatile("s_waitcnt vmcnt(0)" ::: "memory");
        }
    }
    __syncthreads();
}

struct Args { const float* in[N_IN]; float* out; unsigned char* ws; int ph_lo, ph_hi; };

__device__ __forceinline__ const float* inp(const Args& a, int i) { int k = i; asm volatile("" : "+s"(k)); return a.in[k]; }
__device__ __forceinline__ unsigned char* wsp(const Args& a) { size_t z = 0; asm volatile("" : "+s"(z)); return a.ws + z; }
__device__ __forceinline__ float* outp(const Args& a) { size_t z = 0; asm volatile("" : "+s"(z)); return a.out + z; }

__device__ __forceinline__ bool seq_start(int m) { return m == 0 || (m >= MP && ((m - MP) & 63) == 0); }

template <class F> __device__ __forceinline__ void epi_each(const f32x4 (&acc)[2][2][4][2], const pg8::Unit& u, int wr, int wc, int fr, int fq, F&& f) {
#pragma unroll
    for (int ai = 0; ai < 2; ++ai)
#pragma unroll
        for (int m = 0; m < 4; ++m) { const int row = u.pm * 256 + ai * 128 + wr * 64 + m * 16 + fr;
#pragma unroll
            for (int bj = 0; bj < 2; ++bj)
#pragma unroll
                for (int n = 0; n < 2; ++n) f(row, u.pn * 256 + bj * 128 + wc * 32 + n * 16 + fq * 4, acc[ai][bj][m][n]);
            asm volatile("" ::: "memory"); }
}
template <class F> __device__ __forceinline__ void epi_each8(const f32x4 (&acc)[2][2][4][2], const pg8::Unit& u, int wr, int wc, int fr, int fq, F&& f) {
#pragma unroll
    for (int ai = 0; ai < 2; ++ai)
#pragma unroll
        for (int m = 0; m < 4; ++m) { const int row = u.pm * 256 + ai * 128 + wr * 64 + m * 16 + fr;
#pragma unroll
            for (int bj = 0; bj < 2; ++bj) f(row, u.pn * 256 + bj * 128 + wc * 32 + fq * 8, acc[ai][bj][m][0], acc[ai][bj][m][1]);
            asm volatile("" ::: "memory"); }
}

struct EpiEvenIn {
    static constexpr bool PERM = false;
    bf16* U; bf16* ZV; float* QF; float* out; int j;
    __device__ __forceinline__ void operator()(const f32x4 (&acc)[2][2][4][2], const pg8::Unit& u, int wr, int wc, int fr, int fq) const {
        const int grp = u.pn >> 2;
        if (grp == 0) epi_each(acc, u, wr, wc, fr, fq, [&](int row, int col, f32x4 v) { *(v2u*)(U + (size_t)row * 1024 + col) = pk4(gelu4(v)); });
        else if (grp == 1) epi_each(acc, u, wr, wc, fr, fq, [&](int row, int col, f32x4 v) { *(v2u*)(ZV + (size_t)row * 1024 + (col - 1024)) = pk4(gelu4(v)); });
        else if (grp == 2) epi_each(acc, u, wr, wc, fr, fq, [&](int row, int col, f32x4 v) { *(f32x4*)(QF + (size_t)row * 1024 + (col - 2048)) = v; });
        else { float* bp = out + (grp == 3 ? OFF_KP : OFF_VP) + (size_t)j * MP * 1024; float* bs = out + (grp == 3 ? OFF_KS : OFF_VS) + (size_t)j * MS * 1024; const int c0 = grp == 3 ? 3072 : 4096;
            epi_each(acc, u, wr, wc, fr, fq, [&](int row, int col, f32x4 v) { float* d = row < MP ? bp + (size_t)row * 1024 : bs + (size_t)(row - MP) * 1024; *(f32x4*)(d + (col - c0)) = v; }); }
    }
};
struct EpiResid {
    static constexpr bool PERM = false;
    const float* X; float* Y; float* SL;
    __device__ __forceinline__ void operator()(const f32x4 (&acc)[2][2][4][2], const pg8::Unit& u, int wr, int wc, int fr, int fq) const {
        if (u.sp == 0) epi_each(acc, u, wr, wc, fr, fq, [&](int row, int col, f32x4 v) { const size_t o = (size_t)row * D + col; const f32x4 x = *(const f32x4*)(X + o); *(f32x4*)(Y + o) = x * ALPHA + v; });
        else { float* sl = SL + (size_t)(u.sp - 1) * MS * D; epi_each(acc, u, wr, wc, fr, fq, [&](int row, int col, f32x4 v) { *(f32x4*)(sl + (size_t)(row - MP) * D + col) = v; }); }
    }
};
struct EpiFfnIn {
    static constexpr bool PERM = true;
    bf16* HG; bf16* HU; float* out; int layer;
    __device__ __forceinline__ void operator()(const f32x4 (&acc)[2][2][4][2], const pg8::Unit& u, int wr, int wc, int fr, int fq) const {
        if (u.pn < 22) { float* cp = out + OFF_CVP + (size_t)layer * 2 * DFF; float* cs = out + OFF_CVS + (size_t)layer * 16 * 2 * DFF;
            epi_each8(acc, u, wr, wc, fr, fq, [&](int row, int col, f32x4 v0, f32x4 v1) {
                v4u w; w.x = cvt_pk_bf16(v0.x, v0.y); w.y = cvt_pk_bf16(v0.z, v0.w); w.z = cvt_pk_bf16(v1.x, v1.y); w.w = cvt_pk_bf16(v1.z, v1.w);
                *(v4u*)(HG + (size_t)row * DFF + col) = w;
                float* d = nullptr;
                if (row < MP) { if (row >= MP - 2) d = cp + (size_t)(row - (MP - 2)) * DFF; }
                else { const int t = (row - MP) & 63, b = (row - MP) >> 6; if (t >= 62) d = cs + ((size_t)b * 2 + (t - 62)) * DFF; }
                if (d) { *(f32x4*)(d + col) = v0; *(f32x4*)(d + col + 4) = v1; } }); }
        else epi_each8(acc, u, wr, wc, fr, fq, [&](int row, int col, f32x4 v0, f32x4 v1) {
                v4u w; w.x = cvt_pk_bf16(v0.x, v0.y); w.y = cvt_pk_bf16(v0.z, v0.w); w.z = cvt_pk_bf16(v1.x, v1.y); w.w = cvt_pk_bf16(v1.z, v1.w);
                *(v4u*)(HU + (size_t)row * DFF + (col - DFF)) = w; });
    }
};
struct EpiF32 {
    static constexpr bool PERM = false;
    float* C; int ldc;
    __device__ __forceinline__ void operator()(const f32x4 (&acc)[2][2][4][2], const pg8::Unit& u, int wr, int wc, int fr, int fq) const {
        epi_each(acc, u, wr, wc, fr, fq, [&](int row, int col, f32x4 v) { *(f32x4*)(C + (size_t)row * ldc + col) = v; });
    }
};
struct EpiPle {
    static constexpr bool PERM = false;
    float* X; bf16* XB; const float* PPF; float* yout;
    __device__ __forceinline__ void operator()(const f32x4 (&acc)[2][2][4][2], const pg8::Unit& u, int wr, int wc, int fr, int fq) const {
        epi_each(acc, u, wr, wc, fr, fq, [&](int row, int col, f32x4 v) { const size_t o = (size_t)row * D + col; const f32x4 x = *(const f32x4*)(X + o), pp = *(const f32x4*)(PPF + o);
            f32x4 r; r.x = x.x + sigmoid_f(v.x) * pp.x; r.y = x.y + sigmoid_f(v.y) * pp.y; r.z = x.z + sigmoid_f(v.z) * pp.z; r.w = x.w + sigmoid_f(v.w) * pp.w;
            *(f32x4*)(X + o) = r; *(v2u*)(XB + o) = pk4(r); if (yout) *(f32x4*)(yout + o) = r; });
    }
};
struct EpiO1 {
    static constexpr bool PERM = false;
    float* R; float* K; float* V; bf16* H1;
    __device__ __forceinline__ void operator()(const f32x4 (&acc)[2][2][4][2], const pg8::Unit& u, int wr, int wc, int fr, int fq) const {
        const int pn = u.pn;
        if (pn < 8) epi_each(acc, u, wr, wc, fr, fq, [&](int row, int col, f32x4 v) { *(f32x4*)(R + (size_t)row * D + col) = v; });
        else if (pn < 16) epi_each(acc, u, wr, wc, fr, fq, [&](int row, int col, f32x4 v) { *(f32x4*)(K + (size_t)row * D + (col - 2048)) = v; });
        else if (pn < 24) epi_each(acc, u, wr, wc, fr, fq, [&](int row, int col, f32x4 v) { *(f32x4*)(V + (size_t)row * D + (col - 4096)) = v; });
        else {
            const int t = pn - 24; const int lim = t == 3 ? 256 : (t == 2 ? 64 : 96), off = t == 3 ? 256 : 96 * t; const bool ident = (t == 1 || t == 2); const float c1 = t == 0 ? -2.f : -1.f, m = t == 0 ? 2.f : 1.f, ad = t == 0 ? -1.f : 0.f;
            epi_each(acc, u, wr, wc, fr, fq, [&](int row, int col, f32x4 v) { const int lc = col - pn * 256; if (lc < lim) { f32x4 o = v;
                if (!ident) { o.x = m / (1.f + __expf(c1 * v.x)) + ad; o.y = m / (1.f + __expf(c1 * v.y)) + ad; o.z = m / (1.f + __expf(c1 * v.z)) + ad; o.w = m / (1.f + __expf(c1 * v.w)) + ad; }
                *(v2u*)(H1 + (size_t)row * 512 + off + lc) = pk4(o); } }); }
    }
};
struct EpiO2 {
    static constexpr bool PERM = false;
    float* WD; bf16* AA; bf16* VG; bf16* GG; const float* w0; const float* a0; const float* v0;
    __device__ __forceinline__ void operator()(const f32x4 (&acc)[2][2][4][2], const pg8::Unit& u, int wr, int wc, int fr, int fq) const {
        const int grp = u.pn >> 3;
        if (grp == 0) epi_each(acc, u, wr, wc, fr, fq, [&](int row, int col, f32x4 v) { const f32x4 b = *(const f32x4*)(w0 + col); f32x4 r;
            r.x = __expf(-0.6065306597126334f * sigmoid_f(b.x + v.x)); r.y = __expf(-0.6065306597126334f * sigmoid_f(b.y + v.y)); r.z = __expf(-0.6065306597126334f * sigmoid_f(b.z + v.z)); r.w = __expf(-0.6065306597126334f * sigmoid_f(b.w + v.w));
            *(f32x4*)(WD + (size_t)row * D + col) = r; });
        else if (grp == 1) epi_each(acc, u, wr, wc, fr, fq, [&](int row, int col, f32x4 v) { const int c = col - 2048; const f32x4 b = *(const f32x4*)(a0 + c);
            f32x4 r = (f32x4){sigmoid_f(b.x + v.x), sigmoid_f(b.y + v.y), sigmoid_f(b.z + v.z), sigmoid_f(b.w + v.w)}; *(v2u*)(AA + (size_t)row * D + c) = pk4(r); });
        else if (grp == 2) { if (v0) epi_each(acc, u, wr, wc, fr, fq, [&](int row, int col, f32x4 v) { const int c = col - 4096; const f32x4 b = *(const f32x4*)(v0 + c);
            f32x4 r = (f32x4){sigmoid_f(b.x + v.x), sigmoid_f(b.y + v.y), sigmoid_f(b.z + v.z), sigmoid_f(b.w + v.w)}; *(v2u*)(VG + (size_t)row * D + c) = pk4(r); }); }
        else epi_each(acc, u, wr, wc, fr, fq, [&](int row, int col, f32x4 v) { const int c = col - 6144; *(v2u*)(GG + (size_t)row * D + c) = pk4(v); });
    }
};

struct Ctx { int tid, lane, wave, gw, NGW, gtid, NT; LAS unsigned char* lds; };
__device__ __forceinline__ Ctx make_ctx(LAS unsigned char* lds) { Ctx c; int t = threadIdx.x; asm volatile("" : "+v"(t)); c.tid = t; c.lane = t & 63; c.wave = __builtin_amdgcn_readfirstlane(t >> 6); c.lds = lds;
    c.gw = blockIdx.x * NWAVES + c.wave; c.NGW = gridDim.x * NWAVES; c.gtid = blockIdx.x * NTHREADS + t; c.NT = gridDim.x * NTHREADS; return c; }

struct TJD { int src_idx; unsigned long long src_off, dst_off; int K, N, row_off; };
#define TJ_ODD(j)  {I_EWIN, (unsigned long long)(j) * 2048 * 5120, WS_WIN + (j) * SZ_WIN, 2048, 5120, 0}, {I_EWO, (unsigned long long)(j) * 2048 * 2048, WS_WOE + (j) * SZ_W22, 2048, 2048, 0}, \
    {I_CWR, (unsigned long long)(j) * 2048 * 2048, WS_W1T + (j) * SZ_W1T, 2048, 2048, 0}, {I_CWK, (unsigned long long)(j) * 2048 * 2048, WS_W1T + (j) * SZ_W1T, 2048, 2048, 2048}, {I_CWV, (unsigned long long)(j) * 2048 * 2048, WS_W1T + (j) * SZ_W1T, 2048, 2048, 4096}, \
    {I_W1, (unsigned long long)(j) * 2048 * 96, WS_W1T + (j) * SZ_W1T, 2048, 96, 6144}, {I_A1, (unsigned long long)(j) * 2048 * 96, WS_W1T + (j) * SZ_W1T, 2048, 96, 6400}, {I_G1, (unsigned long long)(j) * 2048 * 256, WS_W1T + (j) * SZ_W1T, 2048, 256, 6912}, \
    {I_CWO, (unsigned long long)(j) * 2048 * 2048, WS_WOC + (j) * SZ_W22, 2048, 2048, 0}
#define TJ_FFN(i)  {I_FWIN, (unsigned long long)(i) * 2048 * 11264, WS_FIN + (i) * SZ_FIN, 2048, 11264, 0}, {I_FWOUT, (unsigned long long)(i) * 5632 * 2048, WS_FOUT + (i) * SZ_FOUT, 5632, 2048, 0}, \
    {I_PLEG, (unsigned long long)(i) * 2048 * 2048, WS_WG + (i) * SZ_W22, 2048, 2048, 0}, {I_PLEP, (unsigned long long)(i) * 256 * 2048, WS_WP + (i) * SZ_WP, 256, 2048, 0}
__device__ const TJD tj_table[35] = { TJ_ODD(0), TJ_ODD(1), {I_V1, 0ull, WS_W1T + 1 * SZ_W1T, 2048, 64, 6656}, TJ_FFN(0), TJ_FFN(1), TJ_FFN(2), TJ_FFN(3) };
constexpr int N_TJOBS = 35;
__device__ __forceinline__ void transpose_item(const float* W, int K, int N, bf16* WT, int row_off, LAS float* scr, int item, int lane) {
    const int nblk = N / 32, kb = item / nblk, nb = item % nblk, k0 = 64 * kb, n0 = 32 * nb;
#pragma unroll 8
    for (int i = 0; i < 32; ++i) { const int kk = 2 * i + (lane >> 5); scr[kk * 33 + (lane & 31)] = W[(size_t)(k0 + kk) * N + n0 + (lane & 31)]; }
    LDS_WAIT(); asm volatile("" ::: "memory");
    const int c = lane & 7;
#pragma unroll
    for (int j = 0; j < 4; ++j) { const int n = (lane >> 3) + 8 * j; const LAS float* s = scr + (8 * c) * 33 + n;
        v4u o; o.x = cvt_pk_bf16(s[0 * 33], s[1 * 33]); o.y = cvt_pk_bf16(s[2 * 33], s[3 * 33]); o.z = cvt_pk_bf16(s[4 * 33], s[5 * 33]); o.w = cvt_pk_bf16(s[6 * 33], s[7 * 33]);
        *(v4u*)(WT + (size_t)(row_off + n0 + n) * K + k0 + 8 * c) = o; }
    LDS_WAIT(); asm volatile("" ::: "memory");
}
__device__ __forceinline__ void p0_prologue(const Args& a, const Ctx& c) {
    LAS float* scr = (LAS float*)(c.lds + c.wave * 16384);
    for (int job = 0; job < N_TJOBS; ++job) { const TJD t = tj_table[job]; const int nit = (t.K / 64) * (t.N / 32); const float* src = a.in[t.src_idx] + t.src_off; bf16* dst = (bf16*)(wsp(a) + t.dst_off);
        for (int it = c.gw; it < nit; it += c.NGW) transpose_item(src, t.K, t.N, dst, t.row_off, scr, it, c.lane); }
    const float* pw2 = inp(a, I_W2); const float* pa2 = inp(a, I_A2); const float* pv2 = inp(a, I_V2); const float* pg2 = inp(a, I_G2);
    for (int idx = c.gtid; idx < 2 * 8192 * 32; idx += c.NT) { const int j = idx / (8192 * 32), r = idx % (8192 * 32), k8 = r / 8192, n = r % 8192, k0 = k8 * 8;
        float v[8];
#pragma unroll
        for (int e = 0; e < 8; ++e) { const int k = k0 + e; float x = 0.f;
            if (n < 2048) { if (k < 96) x = pw2[((size_t)j * 96 + k) * 2048 + n]; }
            else if (n < 4096) { if (k >= 96 && k < 192) x = pa2[((size_t)j * 96 + (k - 96)) * 2048 + (n - 2048)]; }
            else if (n < 6144) { if (j == 1 && k >= 192) x = pv2[(size_t)(k - 192) * 2048 + (n - 4096)]; }
            else x = pg2[((size_t)j * 256 + k) * 2048 + (n - 6144)];
            v[e] = x; }
        v4u o; o.x = cvt_pk_bf16(v[0], v[1]); o.y = cvt_pk_bf16(v[2], v[3]); o.z = cvt_pk_bf16(v[4], v[5]); o.w = cvt_pk_bf16(v[6], v[7]);
        *(v4u*)((bf16*)(wsp(a) + WS_W2T + j * SZ_W2T) + (size_t)n * 256 + k0) = o; }
    float* X = (float*)(wsp(a) + WS_X); bf16* XB = (bf16*)(wsp(a) + WS_XB);
    const float* pxp = inp(a, I_XP); const float* pxs = inp(a, I_XS);
    for (int m = c.gw; m < M; m += c.NGW) { const float* src = m < MP ? pxp + (size_t)m * D : pxs + (size_t)(m - MP) * D;
#pragma unroll
        for (int q = 0; q < 8; ++q) { const int col = (c.lane + 64 * q) * 4; const f32x4 v = *(const f32x4*)(src + col); *(f32x4*)(X + (size_t)m * D + col) = v; *(v2u*)(XB + (size_t)m * D + col) = pk4(v); } }
    bf16* PB = (bf16*)(wsp(a) + WS_PB);
    const float* ppp = inp(a, I_PP); const float* pps = inp(a, I_PS);
    for (int idx = c.gtid; idx < 4 * M * 32; idx += c.NT) { const int i = idx / (M * 32), r = idx % (M * 32), m = r / 32, c8 = (r % 32) * 8;
        const float* src = m < MP ? ppp + ((size_t)i * MP + m) * PLE + c8 : pps + ((size_t)i * MS + (m - MP)) * PLE + c8;
        const f32x4 v0 = *(const f32x4*)src, v1 = *(const f32x4*)(src + 4);
        v4u o; o.x = cvt_pk_bf16(v0.x, v0.y); o.y = cvt_pk_bf16(v0.z, v0.w); o.z = cvt_pk_bf16(v1.x, v1.y); o.w = cvt_pk_bf16(v1.z, v1.w);
        *(v4u*)(PB + ((size_t)i * M + m) * PLE + c8) = o; }
}

__device__ __forceinline__ void ln_phase(const float* Y, const float* SL, const float* g, const float* b, float* X, bf16* XB, const Ctx& c) {
    for (int m = c.gw; m < M; m += c.NGW) {
        const f32x4* yr = (const f32x4*)(Y + (size_t)m * D) + c.lane; f32x4 v[8]; float s = 0.f;
#pragma unroll
        for (int q = 0; q < 8; ++q) v[q] = yr[64 * q];
        if (m >= MP) {
#pragma unroll 1
            for (int sp = 0; sp < 7; ++sp) { const f32x4* pr = (const f32x4*)(SL + ((size_t)sp * MS + (m - MP)) * D) + c.lane;
#pragma unroll
                for (int q = 0; q < 8; ++q) v[q] += pr[64 * q]; } }
#pragma unroll
        for (int q = 0; q < 8; ++q) s += (v[q].x + v[q].y) + (v[q].z + v[q].w);
        const float mean = wave_sum(s) * (1.f / D); float s2 = 0.f;
#pragma unroll
        for (int q = 0; q < 8; ++q) { v[q] = v[q] - mean; s2 += (v[q].x * v[q].x + v[q].y * v[q].y) + (v[q].z * v[q].z + v[q].w * v[q].w); }
        const float rstd = 1.f / sqrtf(wave_sum(s2) * (1.f / D) + LN_EPS);
#pragma unroll
        for (int q = 0; q < 8; ++q) { const int col = (c.lane + 64 * q) * 4; const f32x4 g4 = *(const f32x4*)(g + col), b4 = *(const f32x4*)(b + col); const f32x4 o = v[q] * rstd * g4 + b4;
            *(f32x4*)(X + (size_t)m * D + col) = o; *(v2u*)(XB + (size_t)m * D + col) = pk4(o); }
    }
}

__device__ __forceinline__ void mix_phase(const Args& a, int j, const Ctx& c) {
    const float* X = (const float*)(wsp(a) + WS_X); bf16* MIX = (bf16*)(wsp(a) + WS_MIX); const float* mu = inp(a, I_MU) + (size_t)j * 6 * D; const float* shin = inp(a, I_SHIFT);
    for (int m = c.gw; m < M; m += c.NGW) {
        const float* xr = X + (size_t)m * D; const float* xp = xr - D; bool zero_prev = false;
        if (seq_start(m)) { if (m == 0) zero_prev = true; else xp = shin + ((size_t)j * 16 + ((m - MP) >> 6)) * D; }
        float* sh = nullptr;
        if (m == MP - 1) sh = outp(a) + OFF_SHP + (size_t)j * D; else if (m >= MP && ((m - MP) & 63) == 63) sh = outp(a) + OFF_SHS + ((size_t)j * 16 + ((m - MP) >> 6)) * D;
#pragma unroll
        for (int q = 0; q < 8; ++q) { const int col = (c.lane + 64 * q) * 4; const f32x4 x = *(const f32x4*)(xr + col); f32x4 p = (f32x4){0.f, 0.f, 0.f, 0.f}; if (!zero_prev) p = *(const f32x4*)(xp + col);
            const f32x4 dx = p - x;
#pragma unroll
            for (int s = 0; s < 6; ++s) { const f32x4 mu4 = *(const f32x4*)(mu + s * D + col); *(v2u*)(MIX + ((size_t)s * M + m) * D + col) = pk4(x + dx * mu4); }
            if (sh) *(f32x4*)(sh + col) = x; }
    }
}

__device__ __forceinline__ void unpack8(v4u w, float (&f)[8]) { f[0] = bf_lo(w.x); f[1] = bf_hi(w.x); f[2] = bf_lo(w.y); f[3] = bf_hi(w.y); f[4] = bf_lo(w.z); f[5] = bf_hi(w.z); f[6] = bf_lo(w.w); f[7] = bf_hi(w.w); }
__device__ __forceinline__ void load8f(const float* p, float (&f)[8]) { const f32x4 a = *(const f32x4*)p, b = *(const f32x4*)(p + 4); f[0] = a.x; f[1] = a.y; f[2] = a.z; f[3] = a.w; f[4] = b.x; f[5] = b.y; f[6] = b.z; f[7] = b.w; }
__device__ __forceinline__ void act_phase(const Args& a, int layer, const Ctx& c) {
    const bf16* HG = (const bf16*)(wsp(a) + WS_HG); const bf16* HU = (const bf16*)(wsp(a) + WS_HU); bf16* ACT = (bf16*)(wsp(a) + WS_ACT);
    const float* cw = inp(a, I_FCW) + (size_t)layer * 3 * DFF; const float* cb = inp(a, I_FCB) + (size_t)layer * DFF; const float* cst = inp(a, I_CONV);
    constexpr int C8 = DFF / 8;
    for (int idx = c.gtid; idx < M * C8; idx += c.NT) { const int row = idx / C8, col = (idx % C8) * 8;
        const int t = row < MP ? row : ((row - MP) & 63); const float* cprev = row < MP ? nullptr : cst + (((size_t)layer * 16 + ((row - MP) >> 6)) * 2) * DFF;
        float h2[8], h1[8], h0[8], hu[8], w0[8], w1[8], w2[8], bb[8];
        unpack8(*(const v4u*)(HG + (size_t)row * DFF + col), h2); unpack8(*(const v4u*)(HU + (size_t)row * DFF + col), hu);
        if (t >= 1) unpack8(*(const v4u*)(HG + (size_t)(row - 1) * DFF + col), h1);
        else if (cprev) load8f(cprev + DFF + col, h1);
        else {
#pragma unroll
            for (int e = 0; e < 8; ++e) h1[e] = 0.f; }
        if (t >= 2) unpack8(*(const v4u*)(HG + (size_t)(row - 2) * DFF + col), h0);
        else if (cprev) load8f(cprev + (t == 1 ? DFF : 0) + col, h0);
        else {
#pragma unroll
            for (int e = 0; e < 8; ++e) h0[e] = 0.f; }
        load8f(cw + col, w0); load8f(cw + DFF + col, w1); load8f(cw + 2 * DFF + col, w2); load8f(cb + col, bb);
        float o[8];
#pragma unroll
        for (int e = 0; e < 8; ++e) { const float hc = bb[e] + h0[e] * w0[e] + h1[e] * w1[e] + h2[e] * w2[e]; o[e] = gelu_f(hc) * hu[e]; }
        v4u w; w.x = cvt_pk_bf16(o[0], o[1]); w.y = cvt_pk_bf16(o[2], o[3]); w.z = cvt_pk_bf16(o[4], o[5]); w.w = cvt_pk_bf16(o[6], o[7]);
        *(v4u*)(ACT + (size_t)row * DFF + col) = w; }
}

__device__ __forceinline__ void spatial_task(const Args& a, int j, int row0, int n, int h, const Ctx& c) {
    LAS float* vn = (LAS float*)c.lds;
    LAS float* Wl = vn + 128 * 128;
    LAS float* st = Wl + 128 * 132;
    const bf16* ZV = (const bf16*)(wsp(a) + WS_ZV); const bf16* U = (const bf16*)(wsp(a) + WS_U); bf16* AO = (bf16*)(wsp(a) + WS_AO);
    const float* lg = inp(a, I_LNVG) + (size_t)j * AW; const float* lb = inp(a, I_LNVB) + (size_t)j * AW;
    const float* Wg = inp(a, I_EWS) + ((size_t)j * 8 + h) * 128 * 128; const float* bs = inp(a, I_EBS) + ((size_t)j * 8 + h) * 128;
    for (int rr = 0; rr < 16; ++rr) { const int r = c.wave * 16 + rr; if (r < n) {
        const v4u* zr = (const v4u*)(ZV + (size_t)(row0 + r) * AW) + c.lane * 2; float f[16]; { float t8[8]; unpack8(zr[0], t8);
#pragma unroll
            for (int e = 0; e < 8; ++e) f[e] = t8[e]; unpack8(zr[1], t8);
#pragma unroll
            for (int e = 0; e < 8; ++e) f[8 + e] = t8[e]; }
        float s = 0.f;
#pragma unroll
        for (int e = 0; e < 16; ++e) s += f[e];
        const float mean = wave_sum(s) * (1.f / AW); float s2 = 0.f;
#pragma unroll
        for (int e = 0; e < 16; ++e) { const float d = f[e] - mean; s2 += d * d; }
        const float rstd = 1.f / sqrtf(wave_sum(s2) * (1.f / AW) + LN_EPS);
        if (c.lane == 0) { st[r * 2] = mean; st[r * 2 + 1] = rstd; } } }
    for (int k = 0; k < 32; ++k) { const int idx = c.tid + k * NTHREADS, t = idx >> 7, s = idx & 127; Wl[t * 132 + s] = Wg[idx]; }
    __syncthreads();
    float* vaout = (row0 >= MP) ? outp(a) + OFF_VAS + (size_t)j * MS * AW + (size_t)(row0 - MP) * AW + h * 128 : nullptr;
    for (int k = 0; k < 32; ++k) { const int idx = c.tid + k * NTHREADS, s = idx >> 7, cc = idx & 127;
        if (s < n) { const float z = __uint_as_float((unsigned)ZV[(size_t)(row0 + s) * AW + h * 128 + cc] << 16);
            const float v = (z - st[s * 2]) * st[s * 2 + 1] * lg[h * 128 + cc] + lb[h * 128 + cc]; vn[s * 128 + cc] = v; if (vaout) vaout[(size_t)s * AW + cc] = v; } }
    __syncthreads();
    const int t = c.tid >> 2, cq = c.tid & 3;
    if (t < n) { const int s_end = (t < 64) ? 64 : n;
        f32x4 acc[8];
#pragma unroll
        for (int e = 0; e < 8; ++e) acc[e] = (f32x4){0.f, 0.f, 0.f, 0.f};
        for (int s = 0; s < s_end; s += 4) { const f32x4 w4 = *(const LAS f32x4*)(Wl + t * 132 + s);
#pragma unroll
            for (int q = 0; q < 4; ++q) { const float w = w4[q]; const LAS f32x4* vr = (const LAS f32x4*)(vn + (s + q) * 128 + cq * 32);
#pragma unroll
                for (int e = 0; e < 8; ++e) acc[e] += vr[e] * w; } }
        const float bias = bs[t]; const size_t row = (size_t)(row0 + t);
        const v4u* up = (const v4u*)(U + row * AW + h * 128 + cq * 32); v4u* op = (v4u*)(AO + row * D + h * 128 + cq * 32);
#pragma unroll
        for (int e2 = 0; e2 < 4; ++e2) { float uf[8]; unpack8(up[e2], uf); const f32x4 a0 = acc[2 * e2] + bias, a1 = acc[2 * e2 + 1] + bias;
            v4u w; w.x = cvt_pk_bf16(uf[0] * a0.x, uf[1] * a0.y); w.y = cvt_pk_bf16(uf[2] * a0.z, uf[3] * a0.w); w.z = cvt_pk_bf16(uf[4] * a1.x, uf[5] * a1.y); w.w = cvt_pk_bf16(uf[6] * a1.z, uf[7] * a1.w); op[e2] = w; } }
    __syncthreads();
}

typedef float f32x16 __attribute__((ext_vector_type(16)));
typedef short s16x8 __attribute__((ext_vector_type(8)));
typedef short s16x4 __attribute__((ext_vector_type(4)));
__device__ __forceinline__ unsigned cvtpk(float lo, float hi) { typedef float f2_t __attribute__((ext_vector_type(2))); typedef __bf16 b2_t __attribute__((ext_vector_type(2))); f2_t v = {lo, hi}; b2_t b = __builtin_convertvector(v, b2_t); return __builtin_bit_cast(unsigned, b); }
__device__ __forceinline__ s16x8 pack8(float x0, float x1, float x2, float x3, float x4, float x5, float x6, float x7) { v4u w; w.x = cvtpk(x0, x1); w.y = cvtpk(x2, x3); w.z = cvtpk(x4, x5); w.w = cvtpk(x6, x7); return __builtin_bit_cast(s16x8, w); }
__device__ __forceinline__ s16x4 tr_read(const LAS unsigned char* p) { typedef short v4i16_t __attribute__((ext_vector_type(4))); return __builtin_bit_cast(s16x4, __builtin_amdgcn_ds_read_tr16_b64_v4i16((LAS v4i16_t*)p)); }
constexpr int AT_KP = 144, AT_VP = 192, AT_WAVE_LDS = 32 * AT_KP + 32 * AT_VP;
__device__ __forceinline__ void attn_wave_task(const Args& a, int j, int task, const Ctx& c) {
    LAS unsigned char* kl = c.lds + c.wave * AT_WAVE_LDS; LAS unsigned char* vl = kl + 32 * AT_KP;
    const float* QF = (const float*)(wsp(a) + WS_QF); bf16* AO = (bf16*)(wsp(a) + WS_AO);
    int h, row0, pos0, b = 0; const bool smp = task >= 2048;
    if (!smp) { h = task & 15; const int qb = task >> 4; row0 = qb * 64; pos0 = row0; } else { const int s = task - 2048; h = s & 15; b = s >> 4; row0 = MP + b * 64; pos0 = 2048; }
    const int lane = c.lane, r32 = lane & 31, hi = lane >> 5;
    s16x8 qf[2][4];
#pragma unroll
    for (int qt = 0; qt < 2; ++qt)
#pragma unroll
        for (int s = 0; s < 4; ++s) { const float* qp = QF + (size_t)(row0 + qt * 32 + r32) * 1024 + h * 64 + 16 * s + 8 * hi; const f32x4 x0 = *(const f32x4*)qp * 0.125f, x1 = *(const f32x4*)(qp + 4) * 0.125f;
            qf[qt][s] = pack8(x0.x, x0.y, x0.z, x0.w, x1.x, x1.y, x1.z, x1.w); }
    f32x16 o[2][2];
#pragma unroll
    for (int qt = 0; qt < 2; ++qt)
#pragma unroll
        for (int dt = 0; dt < 2; ++dt)
#pragma unroll
            for (int r = 0; r < 16; ++r) o[qt][dt][r] = 0.f;
    float R0 = 0.f, R1 = 0.f;
    const float* kp_new = smp ? outp(a) + OFF_KS + (size_t)j * MS * 1024 + (size_t)(b * 64) * 1024 + h * 64 : outp(a) + OFF_KP + (size_t)j * MP * 1024 + h * 64;
    const float* vp_new = smp ? outp(a) + OFF_VS + (size_t)j * MS * 1024 + (size_t)(b * 64) * 1024 + h * 64 : outp(a) + OFF_VP + (size_t)j * MP * 1024 + h * 64;
    const float* kp_old = inp(a, I_CK) + ((size_t)j * 16 + b) * 2048 * 1024 + h * 64; const float* vp_old = inp(a, I_CV) + ((size_t)j * 16 + b) * 2048 * 1024 + h * 64;
    const LAS unsigned char* vtr = vl + (4 * hi + ((lane & 15) >> 2)) * AT_VP + (16 * ((lane >> 4) & 1) + 4 * (lane & 3)) * 2;
    const LAS unsigned char* kfr = kl + r32 * AT_KP + 16 * hi;
    for (int jt = (pos0 + 64) / 32 - 1; jt >= 0; --jt) {
        const int kpos0 = jt * 32;
        const float* ksrc; const float* vsrc;
        if (smp && kpos0 < 2048) { ksrc = kp_old + (size_t)kpos0 * 1024; vsrc = vp_old + (size_t)kpos0 * 1024; }
        else { const int r = kpos0 - (smp ? 2048 : 0); ksrc = kp_new + (size_t)r * 1024; vsrc = vp_new + (size_t)r * 1024; }
#pragma unroll
        for (int k = 0; k < 8; ++k) { const int e = lane + 64 * k, key = e >> 4, d4 = e & 15;
            *(LAS v2u*)(kl + key * AT_KP + d4 * 8) = pk4(*(const f32x4*)(ksrc + (size_t)key * 1024 + d4 * 4));
            *(LAS v2u*)(vl + key * AT_VP + d4 * 8) = pk4(*(const f32x4*)(vsrc + (size_t)key * 1024 + d4 * 4)); }
        LDS_WAIT(); asm volatile("" ::: "memory");
        f32x16 st0, st1;
#pragma unroll
        for (int r = 0; r < 16; ++r) { st0[r] = 0.f; st1[r] = 0.f; }
#pragma unroll
        for (int s = 0; s < 4; ++s) { const s16x8 kf = *(const LAS s16x8*)(kfr + 32 * s);
            st0 = __builtin_amdgcn_mfma_f32_32x32x16_bf16(kf, qf[0][s], st0, 0, 0, 0); st1 = __builtin_amdgcn_mfma_f32_32x32x16_bf16(kf, qf[1][s], st1, 0, 0, 0); }
#pragma unroll
        for (int qt = 0; qt < 2; ++qt) {
            const int ipos = pos0 + qt * 32 + r32; const float Rc = qt ? R1 : R0;
            float lf[16], ls[16];
#pragma unroll
            for (int r = 0; r < 16; ++r) { const float z = qt ? st1[r] : st0[r]; const bool valid = (kpos0 + (r & 3) + 8 * (r >> 2) + 4 * hi) < ipos;
                const float sp = fmaxf(z, 0.f) + __logf(1.f + __expf(-fabsf(z)));
                lf[r] = valid ? -sp : 0.f; ls[r] = valid ? z - sp : -1e30f; }
            float Gs[4], GP[4];
#pragma unroll
            for (int g = 0; g < 4; ++g) { Gs[g] = (lf[4 * g] + lf[4 * g + 1]) + (lf[4 * g + 2] + lf[4 * g + 3]);
                const auto rr = __builtin_amdgcn_permlane32_swap(__float_as_uint(Gs[g]), __float_as_uint(Gs[g]), false, false); GP[g] = __uint_as_float(hi ? rr[0] : rr[1]); }
            const float T2 = Gs[3], T1 = T2 + Gs[2], T0 = T1 + Gs[1];
            const float P3 = GP[3], P2 = P3 + GP[2], P1 = P2 + GP[1], P0 = P1 + GP[0];
            float later[4]; later[3] = hi ? 0.f : P3; later[2] = T2 + (hi ? P3 : P2); later[1] = T1 + (hi ? P2 : P1); later[0] = T0 + (hi ? P1 : P0);
            float w[16];
#pragma unroll
            for (int g = 0; g < 4; ++g) { const float A3 = Rc + later[g], A2 = A3 + lf[4 * g + 3], A1 = A2 + lf[4 * g + 2], A0 = A1 + lf[4 * g + 1];
                w[4 * g + 3] = __expf(ls[4 * g + 3] + A3); w[4 * g + 2] = __expf(ls[4 * g + 2] + A2); w[4 * g + 1] = __expf(ls[4 * g + 1] + A1); w[4 * g] = __expf(ls[4 * g] + A0); }
            const float Rn = Rc + ((T0 + Gs[0]) + P0);
            if (qt) R1 = Rn; else R0 = Rn;
            const s16x8 pf0 = pack8(w[0], w[1], w[2], w[3], w[4], w[5], w[6], w[7]), pf1 = pack8(w[8], w[9], w[10], w[11], w[12], w[13], w[14], w[15]);
#pragma unroll
            for (int dt = 0; dt < 2; ++dt) {
                const s16x4 v00 = tr_read(vtr + dt * 64), v01 = tr_read(vtr + dt * 64 + 8 * AT_VP), v10 = tr_read(vtr + dt * 64 + 16 * AT_VP), v11 = tr_read(vtr + dt * 64 + 24 * AT_VP);
                const s16x8 vf0 = (s16x8){v00[0], v00[1], v00[2], v00[3], v01[0], v01[1], v01[2], v01[3]}, vf1 = (s16x8){v10[0], v10[1], v10[2], v10[3], v11[0], v11[1], v11[2], v11[3]};
                o[qt][dt] = __builtin_amdgcn_mfma_f32_32x32x16_bf16(pf0, vf0, o[qt][dt], 0, 0, 0);
                o[qt][dt] = __builtin_amdgcn_mfma_f32_32x32x16_bf16(pf1, vf1, o[qt][dt], 0, 0, 0); }
        }
        LDS_WAIT(); asm volatile("" ::: "memory");
        if (__all(R0 < -SB_THRESH && R1 < -SB_THRESH)) break;
    }
#pragma unroll
    for (int qt = 0; qt < 2; ++qt)
#pragma unroll
        for (int dt = 0; dt < 2; ++dt)
#pragma unroll
            for (int r = 0; r < 16; ++r) { const int q = qt * 32 + (r & 3) + 8 * (r >> 2) + 4 * hi;
                AO[(size_t)(row0 + q) * D + 1024 + h * 64 + dt * 32 + r32] = (bf16)(cvtpk(o[qt][dt][r], 0.f) & 0xffffu); }
}
__device__ __forceinline__ void even_mix_phase(const Args& a, int j, const Ctx& c) {
    for (int task = blockIdx.x; task < 928; task += gridDim.x) {
        if (task < 512) spatial_task(a, j, (task >> 3) * 128, 128, task & 7, c);
        else if (task < 640) spatial_task(a, j, MP + ((task - 512) >> 3) * 64, 64, task & 7, c);
        else attn_wave_task(a, j, (task - 640) * 8 + c.wave, c);
    }
}

constexpr int SC_T = 32;
constexpr int SC_BUF = (5 * SC_T * 64 + 2 * SC_T * 16) * 4;
__device__ __forceinline__ void scan_load_chunk(const Args& a, int j, bool first, int row_base, int h, int rg, LAS float* buf, int lt) {
    const int s = lt >> 3, sub = lt & 7, c0 = sub * 8; const size_t off = (size_t)(row_base + s) * D + h * 64 + c0; const int ch = h * 64 + c0;
    float r[8], k[8], v[8], w[8], aa[8], kkp[8], kap[8];
    load8f((const float*)(wsp(a) + WS_R) + off, r); load8f((const float*)(wsp(a) + WS_K) + off, k); load8f((const float*)(wsp(a) + (first ? WS_V1 : WS_V3)) + off, v); load8f((const float*)(wsp(a) + WS_WD) + off, w);
    unpack8(*(const v4u*)((const bf16*)(wsp(a) + WS_AA) + off), aa);
    load8f(inp(a, I_KK) + (size_t)j * D + ch, kkp); load8f(inp(a, I_KA) + (size_t)j * D + ch, kap);
    if (!first) { float vf[8], vg[8]; load8f((const float*)(wsp(a) + WS_V1) + off, vf); unpack8(*(const v4u*)((const bf16*)(wsp(a) + WS_VG) + off), vg);
#pragma unroll
        for (int e = 0; e < 8; ++e) v[e] = v[e] + (vf[e] - v[e]) * vg[e]; }
    float kk[8], ss = 0.f;
#pragma unroll
    for (int e = 0; e < 8; ++e) { kk[e] = k[e] * kkp[e]; ss += kk[e] * kk[e]; }
    ss = reduce8(ss);
    const float inv = 1.f / fmaxf(sqrtf(ss), 1e-12f);
    LAS float* pr = buf + s * 64 + c0; LAS float* pw = pr + SC_T * 64; LAS float* pk = pw + SC_T * 64; LAS float* pa = pk + SC_T * 64; LAS float* pb = pa + SC_T * 64;
    float o_k[8], o_a[8], o_b[8];
#pragma unroll
    for (int e = 0; e < 8; ++e) { const float kn = kk[e] * inv; o_k[e] = k[e] * (1.f + (aa[e] - 1.f) * kap[e]); o_a[e] = -kn; o_b[e] = kn * aa[e]; }
#pragma unroll
    for (int q = 0; q < 2; ++q) { *(LAS f32x4*)(pr + 4 * q) = (f32x4){r[4 * q], r[4 * q + 1], r[4 * q + 2], r[4 * q + 3]}; *(LAS f32x4*)(pw + 4 * q) = (f32x4){w[4 * q], w[4 * q + 1], w[4 * q + 2], w[4 * q + 3]};
        *(LAS f32x4*)(pk + 4 * q) = (f32x4){o_k[4 * q], o_k[4 * q + 1], o_k[4 * q + 2], o_k[4 * q + 3]}; *(LAS f32x4*)(pa + 4 * q) = (f32x4){o_a[4 * q], o_a[4 * q + 1], o_a[4 * q + 2], o_a[4 * q + 3]};
        *(LAS f32x4*)(pb + 4 * q) = (f32x4){o_b[4 * q], o_b[4 * q + 1], o_b[4 * q + 2], o_b[4 * q + 3]}; }
    if ((sub >> 1) == rg) { LAS float* pv = buf + 5 * SC_T * 64 + s * 16 + (sub & 1) * 8;
        *(LAS f32x4*)pv = (f32x4){v[0], v[1], v[2], v[3]}; *(LAS f32x4*)(pv + 4) = (f32x4){v[4], v[5], v[6], v[7]}; }
}
__device__ __forceinline__ void scan_store_y(const Args& a, int row_base, int h, int rg, const LAS float* buf, int lt) {
    const LAS float* yb = buf + 5 * SC_T * 64 + SC_T * 16; float* YS = (float*)(wsp(a) + WS_YS);
#pragma unroll
    for (int k = 0; k < 2; ++k) { const int idx = lt + 256 * k, s = idx >> 4, i = idx & 15; YS[(size_t)(row_base + s) * D + h * 64 + rg * 16 + i] = yb[s * 16 + i]; }
}
__device__ __forceinline__ void scan_phase(const Args& a, int j, const Ctx& c) {
    const bool first = (j == 0); const int G = gridDim.x, bid = blockIdx.x;
    constexpr int NPT = 128, NST = 2048;
    for (int it = 0;; ++it) {
        int task;
        if (G > NPT) { if (bid < NPT) { if (it > 0) break; task = bid; } else { task = NPT + (bid - NPT) + it * (G - NPT); if (task >= NPT + NST) break; } }
        else { task = bid + it * G; if (task >= NPT + NST) break; }
        int h, rg, row0, T; const float* s0 = nullptr; float* sout;
        if (task < NPT) { h = task >> 2; rg = task & 3; row0 = 0; T = MP; sout = outp(a) + OFF_WKVP + ((size_t)j * 32 + h) * 4096; }
        else { const int s = task - NPT, b = s >> 7; h = (s >> 2) & 31; rg = s & 3; row0 = MP + b * 64; T = 64; const size_t so = (((size_t)j * 16 + b) * 32 + h) * 4096; s0 = inp(a, I_WKV) + so; sout = outp(a) + OFF_WKVS + so; }
        const int nch = T / SC_T;
        LAS float* buf0 = (LAS float*)c.lds; LAS float* buf1 = (LAS float*)(c.lds + SC_BUF);
        const int jq = c.lane & 15, il = c.wave * 4 + (c.lane >> 4);
        f32x4 S = (f32x4){0.f, 0.f, 0.f, 0.f};
        if (c.wave < 4) { if (s0) S = *(const f32x4*)(s0 + (size_t)(rg * 16 + il) * 64 + 4 * jq); }
        else scan_load_chunk(a, j, first, row0, h, rg, buf0, c.tid - 256);
        __syncthreads();
        for (int ch = 0; ch < nch; ++ch) {
            LAS float* cur = (ch & 1) ? buf1 : buf0; LAS float* oth = (ch & 1) ? buf0 : buf1;
            if (c.wave < 4) {
                const LAS float* pr = cur + 4 * jq; LAS float* yb = cur + 5 * SC_T * 64 + SC_T * 16; const LAS float* pv = cur + 5 * SC_T * 64 + il;
                f32x4 r_[4], w_[4], k_[4], a_[4], b_[4]; float v_[4];
#define SC_LD(s, t) do { r_[s] = *(const LAS f32x4*)(pr + (t) * 64); w_[s] = *(const LAS f32x4*)(pr + (SC_T + (t)) * 64); k_[s] = *(const LAS f32x4*)(pr + (2 * SC_T + (t)) * 64); \
                         a_[s] = *(const LAS f32x4*)(pr + (3 * SC_T + (t)) * 64); b_[s] = *(const LAS f32x4*)(pr + (4 * SC_T + (t)) * 64); v_[s] = pv[(t) * 16]; } while (0)
#define DPP2(CTRL) do { pa += dpp_f<CTRL>(pa); yq += dpp_f<CTRL>(yq); } while (0)
                SC_LD(0, 0); SC_LD(1, 1); SC_LD(2, 2);
                float ykeep = 0.f, yq = 0.f;
                f32x2 S01 = (f32x2){S.x, S.y}, S23 = (f32x2){S.z, S.w};
#pragma unroll
                for (int t = 0; t < SC_T; ++t) {
                    const int s = t & 3;
                    if (t + 3 < SC_T) SC_LD((t + 3) & 3, t + 3);
                    f32x2 p = S01 * (f32x2){a_[s].x, a_[s].y}; p = S23 * (f32x2){a_[s].z, a_[s].w} + p;
                    float pa = p.x + p.y;
                    const f32x2 kv01 = (f32x2){k_[s].x, k_[s].y} * v_[s], kv23 = (f32x2){k_[s].z, k_[s].w} * v_[s];
                    DPP2(0xB1); DPP2(0x4E); DPP2(0x141); DPP2(0x140);
                    if (t > 0) { ykeep = (jq == ((t - 1) & 15)) ? yq : ykeep; if (((t - 1) & 15) == 15) yb[(t - 16 + jq) * 16 + il] = ykeep; }
                    S01 = S01 * (f32x2){w_[s].x, w_[s].y} + kv01; S23 = S23 * (f32x2){w_[s].z, w_[s].w} + kv23;
                    S01 = (f32x2){b_[s].x, b_[s].y} * pa + S01; S23 = (f32x2){b_[s].z, b_[s].w} * pa + S23;
                    f32x2 q2 = S01 * (f32x2){r_[s].x, r_[s].y}; q2 = S23 * (f32x2){r_[s].z, r_[s].w} + q2;
                    yq = q2.x + q2.y;
                }
                yq = reduce16(yq); ykeep = (jq == ((SC_T - 1) & 15)) ? yq : ykeep; yb[(SC_T - 16 + jq) * 16 + il] = ykeep;
                S = (f32x4){S01.x, S01.y, S23.x, S23.y};
#undef DPP2
#undef SC_LD
            } else {
                const int lt = c.tid - 256;
                if (ch > 0) scan_store_y(a, row0 + (ch - 1) * SC_T, h, rg, oth, lt);
                if (ch + 1 < nch) { LDS_WAIT(); scan_load_chunk(a, j, first, row0 + (ch + 1) * SC_T, h, rg, oth, lt); }
            }
            __syncthreads();
        }
        if (c.wave >= 4) scan_store_y(a, row0 + (nch - 1) * SC_T, h, rg, ((nch - 1) & 1) ? buf1 : buf0, c.tid - 256);
        else *(f32x4*)(sout + (size_t)(rg * 16 + il) * 64 + 4 * jq) = S;
        __syncthreads();
    }
}

__device__ __forceinline__ void post_phase(const Args& a, int j, const Ctx& c) {
    const bool first = (j == 0);
    const float* YS = (const float*)(wsp(a) + WS_YS); const float* R = (const float*)(wsp(a) + WS_R); const float* K = (const float*)(wsp(a) + WS_K); const float* V = (const float*)(wsp(a) + (first ? WS_V1 : WS_V3));
    const float* VF = (const float*)(wsp(a) + WS_V1); const bf16* AA = (const bf16*)(wsp(a) + WS_AA); const bf16* VG = (const bf16*)(wsp(a) + WS_VG); const bf16* GG = (const bf16*)(wsp(a) + WS_GG); bf16* YG = (bf16*)(wsp(a) + WS_YG);
    const float* kap = inp(a, I_KA) + (size_t)j * D; const float* rkp = inp(a, I_RK) + (size_t)j * D; const float* gng = inp(a, I_GNG) + (size_t)j * D; const float* gnb = inp(a, I_GNB) + (size_t)j * D;
    const int g = c.lane >> 4, l16 = c.lane & 15;
    for (int wi = c.gw; wi < M * 32 / 4; wi += c.NGW) { const int item = wi * 4 + g, row = item >> 5, h = item & 31, ch = h * 64 + l16 * 4; const size_t off = (size_t)row * D + ch;
        const f32x4 y = *(const f32x4*)(YS + off), r = *(const f32x4*)(R + off), k = *(const f32x4*)(K + off); f32x4 v = *(const f32x4*)(V + off);
        const v2u aw = *(const v2u*)(AA + off), gw2 = *(const v2u*)(GG + off);
        const f32x4 aa = (f32x4){bf_lo(aw.x), bf_hi(aw.x), bf_lo(aw.y), bf_hi(aw.y)}, gg = (f32x4){bf_lo(gw2.x), bf_hi(gw2.x), bf_lo(gw2.y), bf_hi(gw2.y)};
        if (!first) { const f32x4 vf = *(const f32x4*)(VF + off); const v2u vw = *(const v2u*)(VG + off); const f32x4 vg = (f32x4){bf_lo(vw.x), bf_hi(vw.x), bf_lo(vw.y), bf_hi(vw.y)}; v = v + (vf - v) * vg; }
        const f32x4 ka4 = *(const f32x4*)(kap + ch), rk4 = *(const f32x4*)(rkp + ch), g4 = *(const f32x4*)(gng + ch), b4 = *(const f32x4*)(gnb + ch);
        const f32x4 k2 = k * ((aa - 1.f) * ka4 + 1.f);
        const float mean = reduce16((y.x + y.y) + (y.z + y.w)) * (1.f / 64.f); const f32x4 dy = y - mean;
        const float var = reduce16((dy.x * dy.x + dy.y * dy.y) + (dy.z * dy.z + dy.w * dy.w)) * (1.f / 64.f);
        const float rstd = 1.f / sqrtf(var + GN_EPS);
        const f32x4 rk = r * k2 * rk4; const float bonus = reduce16((rk.x + rk.y) + (rk.z + rk.w));
        const f32x4 o = (dy * rstd * g4 + b4 + v * bonus) * gg;
        *(v2u*)(YG + off) = pk4(o); }
}

constexpr int N_PHASES = 1 + 12 * 4;
__host__ __device__ constexpr bool phase_exists(int ph) { return ph == 0 || (ph < N_PHASES && !((((ph - 1) / 12) & 1) == 0 && ((ph - 1) % 12) >= 2 && ((ph - 1) % 12) <= 4)); }

__global__ void __launch_bounds__(NTHREADS, 2) fwd_kernel(Args args) {
    extern __shared__ __attribute__((aligned(16))) unsigned char lds_raw[];
    LAS unsigned char* lds = (LAS unsigned char*)lds_raw;
    const int G = gridDim.x;
    const int lo = args.ph_lo, hi = args.ph_hi; const bool fused = (hi - lo) > 1;
    if (threadIdx.x < 64) ((LAS unsigned*)(lds + LDSCTL_OFF))[threadIdx.x] = 0u;
    __syncthreads();
    XcdBarrier bar; bar.bar = (unsigned*)(wsp(args) + WS_CTL) + CW_BAR; bar.x = 0; bar.st = nullptr;
    if (fused) bar = xcd_barrier_post((unsigned*)(wsp(args) + WS_CTL) + CW_BAR, (volatile LAS unsigned*)(lds + LDSCTL_OFF));
#ifndef PHMASK
#define PHMASK 0xFFFFu
#endif
#define SEL(b) (((PHMASK) >> (b)) & 1u)
#define IN(k) (lo <= (k) && (k) < hi)
#define SEAM() do { if (fused) xcd_barrier(bar); } while (0)

#ifndef PROBE_MASK
#define PROBE_MASK 0u
#endif
#define PROBE(b) (((PROBE_MASK) >> (b)) & 1u)
#define SITE(bit, ph, ...) do { if (SEL(bit) && IN(ph)) { { __VA_ARGS__ } SEAM(); if (PROBE(bit)) { { __VA_ARGS__ } SEAM(); } } } while (0)

    SITE(0, 0, const Ctx c = make_ctx(lds); p0_prologue(args, c););

    for (int L = 0; L < 4; ++L) {
        const int base = 1 + 12 * L, j = L >> 1;
#define ws wsp(args)
#define X ((float*)(wsp(args) + WS_X))
#define XB ((bf16*)(wsp(args) + WS_XB + (size_t)(L & 1) * SZ_X16))
#define XBN ((bf16*)(wsp(args) + WS_XB + (size_t)((L + 1) & 1) * SZ_X16))
#define Y ((float*)(wsp(args) + WS_Y))
        if ((L & 1) == 0) {
            SITE(1, base + 0,
                pg8::Gemm g{XB, (const bf16*)(ws + WS_WIN + j * SZ_WIN), M, EVEN_IN, D, D, 0ull, 0ull, 0};
                pg8::StaticOrder S; S.init(M, EVEN_IN, G, (int)blockIdx.x);
                EpiEvenIn E{(bf16*)(ws + WS_U), (bf16*)(ws + WS_ZV), (float*)(ws + WS_QF), outp(args), j};
                pg8::gemm_phase<EpiEvenIn, pg8::StaticOrder, true>(lds, g, S, E););
            SITE(2, base + 1, const Ctx c = make_ctx(lds); even_mix_phase(args, j, c););
            SITE(3, base + 5,
                pg8::Gemm g{(const bf16*)(ws + WS_AO), (const bf16*)(ws + WS_WOE + j * SZ_W22), M, D, D, D, 0ull, 0ull, 0};
                pg8::SplitOrder S; S.init(D, G, (int)blockIdx.x);
                EpiResid E{X, Y, (float*)(ws + WS_SLAB)};
                pg8::gemm_phase<EpiResid, pg8::SplitOrder, true>(lds, g, S, E););
        } else {
            SITE(4, base + 0, const Ctx c = make_ctx(lds); mix_phase(args, j, c););
            SITE(5, base + 1,
                pg8::Gemm g{(const bf16*)(ws + WS_MIX), (const bf16*)(ws + WS_W1T + j * SZ_W1T), M, N_O1, D, D, 0x2222222200000000ull, 0x0000534133333333ull, (size_t)M * D};
                pg8::StaticOrder S; S.init(M, N_O1, G, (int)blockIdx.x);
                EpiO1 E{(float*)(ws + WS_R), (float*)(ws + WS_K), (float*)(ws + (j == 0 ? WS_V1 : WS_V3)), (bf16*)(ws + WS_H1)};
                pg8::gemm_phase<EpiO1, pg8::StaticOrder, true>(lds, g, S, E););
            SITE(6, base + 2,
                pg8::Gemm g{(const bf16*)(ws + WS_H1), (const bf16*)(ws + WS_W2T + j * SZ_W2T), M, N_O2, 256, 512, 0ull, 0x1111111100000000ull, 256};
                pg8::StaticOrder S; S.init(M, N_O2, G, (int)blockIdx.x);
                EpiO2 E{(float*)(ws + WS_WD), (bf16*)(ws + WS_AA), (bf16*)(ws + WS_VG), (bf16*)(ws + WS_GG), inp(args, I_W0) + (size_t)j * D, inp(args, I_A0) + (size_t)j * D, j == 0 ? nullptr : inp(args, I_V0)};
                pg8::gemm_phase<EpiO2, pg8::StaticOrder, true>(lds, g, S, E););
            SITE(7, base + 3, const Ctx c = make_ctx(lds); scan_phase(args, j, c););
            SITE(8, base + 4, const Ctx c = make_ctx(lds); post_phase(args, j, c););
            SITE(9, base + 5,
                pg8::Gemm g{(const bf16*)(ws + WS_YG), (const bf16*)(ws + WS_WOC + j * SZ_W22), M, D, D, D, 0ull, 0ull, 0};
                pg8::SplitOrder S; S.init(D, G, (int)blockIdx.x);
                EpiResid E{X, Y, (float*)(ws + WS_SLAB)};
                pg8::gemm_phase<EpiResid, pg8::SplitOrder, true>(lds, g, S, E););
        }
        SITE(10, base + 6, const Ctx c = make_ctx(lds); ln_phase(Y, (const float*)(wsp(args) + WS_SLAB), inp(args, I_LN1G) + (size_t)L * D, inp(args, I_LN1B) + (size_t)L * D, X, XB, c););
        SITE(11, base + 7,
            pg8::Gemm g{XB, (const bf16*)(ws + WS_FIN + L * SZ_FIN), M, 2 * DFF, D, D, 0ull, 0ull, 0};
            pg8::StaticOrder S; S.init(M, 2 * DFF, G, (int)blockIdx.x);
            EpiFfnIn E{(bf16*)(ws + WS_HG), (bf16*)(ws + WS_HU), outp(args), L};
            pg8::gemm_phase<EpiFfnIn, pg8::StaticOrder, true>(lds, g, S, E););
        SITE(12, base + 8,
            { const Ctx c = make_ctx(lds); act_phase(args, L, c); }
            __syncthreads();
            pg8::Gemm g{(const bf16*)(ws + WS_PB + L * SZ_PB), (const bf16*)(ws + WS_WP + L * SZ_WP), M, D, PLE, PLE, 0ull, 0ull, 0};
            pg8::StaticOrder S; S.init(M, D, G, (int)blockIdx.x);
            EpiF32 E{(float*)(ws + WS_PPF), D};
            pg8::gemm_phase<EpiF32, pg8::StaticOrder, true>(lds, g, S, E););
        SITE(13, base + 9,
            pg8::Gemm g{(const bf16*)(ws + WS_ACT), (const bf16*)(ws + WS_FOUT + L * SZ_FOUT), M, D, DFF, DFF, 0ull, 0ull, 0};
            pg8::SplitOrder S; S.init(DFF, G, (int)blockIdx.x);
            EpiResid E{X, Y, (float*)(ws + WS_SLAB)};
            pg8::gemm_phase<EpiResid, pg8::SplitOrder, true>(lds, g, S, E););
        SITE(14, base + 10, const Ctx c = make_ctx(lds); ln_phase(Y, (const float*)(wsp(args) + WS_SLAB), inp(args, I_LN2G) + (size_t)L * D, inp(args, I_LN2B) + (size_t)L * D, X, XB, c););
        if (SEL(15) && IN(base + 11)) {
            pg8::Gemm g{XB, (const bf16*)(ws + WS_WG + L * SZ_W22), M, D, D, D, 0ull, 0ull, 0};
            pg8::StaticOrder S; S.init(M, D, G, (int)blockIdx.x);
            EpiPle E{X, XBN, (const float*)(ws + WS_PPF), L == 3 ? outp(args) : nullptr};
            pg8::gemm_phase<EpiPle, pg8::StaticOrder, true>(lds, g, S, E);
            SEAM();
        }
    }
#undef IN
#undef SEAM
#undef ws
#undef X
#undef XB
#undef XBN
#undef Y
}

extern "C" void kernel_launch(void* const* d_in, const int* in_sizes, int n_in, void* d_out, int out_size, void* d_ws, size_t ws_size, hipStream_t stream) {
    static int grid = 0;
    if (grid == 0) {
        if (n_in != N_IN || out_size != (int)OUT_END || ws_size < WS_END) { fprintf(stderr, "kernel_launch: unexpected problem shape (n_in %d, out %d, ws %zu; need %d, %zu, %zu)\n", n_in, out_size, ws_size, (int)N_IN, (size_t)OUT_END, (size_t)WS_END); grid = -1; return; }
        int dev = 0, cus = 0, per_cu = 0;
        if (hipGetDevice(&dev) != hipSuccess || hipDeviceGetAttribute(&cus, hipDeviceAttributeMultiprocessorCount, dev) != hipSuccess) { grid = -1; return; }
        if (hipFuncSetAttribute((const void*)fwd_kernel, hipFuncAttributeMaxDynamicSharedMemorySize, LDS_BYTES) != hipSuccess) { fprintf(stderr, "kernel_launch: hipFuncSetAttribute failed\n"); grid = -1; return; }
        if (hipOccupancyMaxActiveBlocksPerMultiprocessor(&per_cu, (const void*)fwd_kernel, NTHREADS, LDS_BYTES) != hipSuccess || per_cu < 1) fprintf(stderr, "kernel_launch: occupancy query reports %d\n", per_cu);
        (void)hipGetLastError();
        grid = cus;
    }
    if (grid < 0) return;
    (void)in_sizes;
    if (hipMemsetAsync((char*)d_ws + WS_CTL, 0, CTL_ZERO_BYTES, stream) != hipSuccess) return;
    Args a{};
    for (int i = 0; i < N_IN; ++i) a.in[i] = (const float*)d_in[i];
    a.out = (float*)d_out; a.ws = (unsigned char*)d_ws;
#if MK_ONE_LAUNCH
    a.ph_lo = 0; a.ph_hi = N_PHASES;
    hipLaunchKernelGGL(fwd_kernel, dim3(grid), dim3(NTHREADS), LDS_BYTES, stream, a);
#else
    for (int ph = 0; ph < N_PHASES; ++ph) { if (!phase_exists(ph)) continue; a.ph_lo = ph; a.ph_hi = ph + 1;
        hipLaunchKernelGGL(fwd_kernel, dim3(grid), dim3(NTHREADS), LDS_BYTES, stream, a); }
#endif
}
```

```cpp
#include <hip/hip_runtime.h>
#include <cstdio>
#include <cstdint>

#ifndef MK_ONE_LAUNCH
#define MK_ONE_LAUNCH 1
#endif

namespace pg8 {
#define PG8_LAS __attribute__((address_space(3)))
typedef unsigned short bf16_t;
typedef short bf16x8 __attribute__((ext_vector_type(8)));
typedef float f32x4 __attribute__((ext_vector_type(4)));
typedef unsigned u32x4 __attribute__((ext_vector_type(4)));
typedef unsigned u32x2 __attribute__((ext_vector_type(2)));
constexpr int BM = 256, BK = 64, HALF = 128, HTB = HALF * BK * 2  , STAGE_BYTES = 8 * HTB, NXCD = 8, WGM = 8;

__host__ __device__ __forceinline__ int lds_byte(int r, int c) { const int st = (r >> 4) * 2 + (c >> 5), rr = r & 15, cc = c & 31, ob = rr * 64 + cc * 2; return st * 1024 + (ob ^ (((ob >> 9) & 1) << 5)); }
__host__ __device__ __forceinline__ void stage_rc(int b, int& R, int& C) { const int st = b / 1024, sb = b % 1024, swz = sb ^ (((sb >> 9) & 1) << 5); R = (st >> 1) * 16 + swz / 64; C = (st & 1) * 32 + (swz % 64) / 2; }
__host__ __device__ __forceinline__ int perm32(int rho) { const int n = rho >> 4, i = rho & 15; return 8 * (i >> 2) + 4 * n + (i & 3); }

struct Unit { int pm, pn, k0, nt, sp; };
struct Gemm { const bf16_t* A; const bf16_t* Bt; int M, N, K, lda; unsigned long long asel0, asel1; size_t asel_stride; };
__device__ __forceinline__ const char* a_base(const Gemm& g, const Unit& u) {
    size_t off = 0;
    if (g.asel_stride) { const unsigned sel = (unsigned)(((u.pn < 16) ? (g.asel0 >> (4 * u.pn)) : (g.asel1 >> (4 * (u.pn & 15)))) & 15ull); off = (size_t)sel * g.asel_stride; }
    return (const char*)(g.A + off) + (size_t)u.pm * ((size_t)BM * g.lda * 2) + (size_t)u.k0 * 2;
}

__host__ __device__ __forceinline__ void tile_of(int wgid, int nM, int nN, Unit& u) {
    const int nwg = nM * nN; { const int q = nwg / NXCD, r = nwg % NXCD, xcd = wgid % NXCD, off = wgid / NXCD; wgid = (xcd < r ? xcd * (q + 1) : r * (q + 1) + (xcd - r) * q) + off; }
    const int nig = WGM * nN, gid = wgid / nig, fm = gid * WGM, gsz = (nM - fm) < WGM ? (nM - fm) : WGM;
    u.pm = fm + ((wgid % nig) % gsz); u.pn = (wgid % nig) / gsz; u.k0 = 0; u.nt = -1; u.sp = 0;
}
struct StaticOrder {
    int nM, nN, nwg, G, c;
    __host__ __device__ void init(int M, int N, int G_, int c_) { nM = M / BM; nN = N / BM; nwg = nM * nN; G = G_; c = c_; }
    __host__ __device__ bool next(int i, Unit& u) const { const long L = (long)i * G + c; if (L >= nwg) return false; tile_of((int)L, nM, nN, u); return true; }
    __device__ __forceinline__ void a_ready(const Unit&) const {}
    __device__ __forceinline__ void done(const Unit&) const {}
};
struct SplitOrder {
    int G, c, nchunk;
    __host__ __device__ void init(int K, int G_, int c_) { G = G_; c = c_; nchunk = K / 128; }
    __host__ __device__ bool next(int i, Unit& u) const {
        const long L = (long)i * G + c;
        if (L < 256) { tile_of((int)L, 32, 8, u); return true; }
        const int v = (int)(L - 256); if (v >= 256) return false;
        const int tile = v & 31, s = v >> 5, c0 = (nchunk * s) >> 3, c1 = (nchunk * (s + 1)) >> 3;
        u.pm = 32 + (tile >> 3); u.pn = tile & 7; u.k0 = c0 * 128; u.nt = (c1 - c0) * 2; u.sp = s; return true;
    }
    __device__ __forceinline__ void a_ready(const Unit&) const {}
    __device__ __forceinline__ void done(const Unit&) const {}
};

__device__ __forceinline__ unsigned cvt_pk_bf16(float lo, float hi) { typedef float f2_t __attribute__((ext_vector_type(2))); typedef __bf16 b2_t __attribute__((ext_vector_type(2))); f2_t v = {lo, hi}; b2_t b = __builtin_convertvector(v, b2_t); return __builtin_bit_cast(unsigned, b); }

template <class Epi, class Sched, bool ALIGN_EPI = false>
__device__ __forceinline__ void gemm_phase(PG8_LAS unsigned char* lds, const Gemm g, const Sched& S, const Epi& E) {
    int tid_ = threadIdx.x; asm volatile("" : "+v"(tid_));
    const int tid = tid_, wid = __builtin_amdgcn_readfirstlane(tid >> 6), lane = tid & 63, wr = wid >> 2, wc = wid & 3, fr = lane & 15, fq = lane >> 4;
    const int K = g.K, nt = K / BK, lda = g.lda;
    unsigned voffA[2], voffB[2];
#pragma unroll
    for (int i = 0; i < 2; ++i) { int R, C; stage_rc(tid * 16 + i * 8192, R, C); const int Rb = Epi::PERM ? ((R & ~31) + perm32(R & 31)) : R;
        voffA[i] = (unsigned)(R * lda + C) * 2u; voffB[i] = (unsigned)(Rb * K + C) * 2u; }
    const size_t kstep = (size_t)(BK * 2);
    const size_t hstepA = (size_t)HALF * lda * 2, hstepB = (size_t)HALF * K * 2;
    const size_t tstepB = 2 * hstepB;
    const unsigned ldsw = (unsigned)wid * 1024u;
    const int aoff = lds_byte(wr * 64 + fr, fq * 8), boff = lds_byte(wc * 32 + fr, fq * 8);
#define PG8_SA(b, h) (((b) * 2 + (h)) * HTB)
#define PG8_SB(b, h) ((4 + (b) * 2 + (h)) * HTB)
#define PG8_STAGE(bufoff, gbase, voff) do { _Pragma("unroll") for (int _i = 0; _i < 2; ++_i) \
        __builtin_amdgcn_global_load_lds((const unsigned*)((const char*)(gbase) + (voff)[_i]), (PG8_LAS unsigned*)(lds + (bufoff) + ldsw + _i * 8192), 16, 0, 0); } while (0)
#define PG8_LDA(dst, b, h) do { _Pragma("unroll") for (int m = 0; m < 4; ++m) _Pragma("unroll") for (int k = 0; k < 2; ++k) dst[m][k] = *(const PG8_LAS bf16x8*)(lds + PG8_SA(b, h) + aoff + m * 2048 + k * 1024); } while (0)
#define PG8_LDB(dst, b, h) do { _Pragma("unroll") for (int n = 0; n < 2; ++n) _Pragma("unroll") for (int k = 0; k < 2; ++k) dst[n][k] = *(const PG8_LAS bf16x8*)(lds + PG8_SB(b, h) + boff + n * 2048 + k * 1024); } while (0)
#define PG8_MMA(ai, bj, At, Bt) do { __builtin_amdgcn_s_setprio(1); _Pragma("unroll") for (int m = 0; m < 4; ++m) _Pragma("unroll") for (int n = 0; n < 2; ++n) _Pragma("unroll") for (int k = 0; k < 2; ++k) \
        acc[ai][bj][m][n] = __builtin_amdgcn_mfma_f32_16x16x32_bf16(Bt[n][k], At[m][k], acc[ai][bj][m][n], 0, 0, 0); __builtin_amdgcn_s_setprio(0); } while (0)
#define PG8_WAIT_V(n) asm volatile("s_waitcnt vmcnt(" #n ")" ::: "memory")
#define PG8_WAIT_L(n) asm volatile("s_waitcnt lgkmcnt(" #n ")" ::: "memory")
#define PG8_BAR __builtin_amdgcn_s_barrier()
#define PG8_SCHED __builtin_amdgcn_sched_barrier(0)
    Unit cur, nxt; int ui = 0;
    if (!S.next(0, cur)) return;
    f32x4 acc[2][2][4][2];
#pragma unroll
    for (int a = 0; a < 2; ++a)
#pragma unroll
        for (int b = 0; b < 2; ++b)
#pragma unroll
            for (int m = 0; m < 4; ++m)
#pragma unroll
                for (int n = 0; n < 2; ++n) acc[a][b][m][n] = (f32x4){0.f, 0.f, 0.f, 0.f};
    bf16x8 At[4][2], B0[2][2], B1[2][2];
    const char* cA = a_base(g, cur); const char* cB = (const char*)g.Bt + (size_t)cur.pn * tstepB + (size_t)cur.k0 * 2;
    S.a_ready(cur);
    PG8_STAGE(PG8_SB(0, 0), cB, voffB); PG8_STAGE(PG8_SB(0, 1), cB + hstepB, voffB); PG8_STAGE(PG8_SA(0, 0), cA, voffA); PG8_STAGE(PG8_SA(0, 1), cA + hstepA, voffA);
    if (wr == 1) PG8_BAR;
    PG8_WAIT_V(2); PG8_BAR;
    PG8_STAGE(PG8_SB(1, 0), cB + kstep, voffB); PG8_STAGE(PG8_SA(1, 0), cA + kstep, voffA); PG8_STAGE(PG8_SB(1, 1), cB + hstepB + kstep, voffB);
    PG8_WAIT_V(6); PG8_BAR;
    for (;;) {
        const bool has_next = S.next(ui + 1, nxt);
        const char* nA = has_next ? a_base(g, nxt) : cA; const char* nB = has_next ? (const char*)g.Bt + (size_t)nxt.pn * tstepB + (size_t)nxt.k0 * 2 : cB;
        const int unt = cur.nt < 0 ? nt : cur.nt;
#pragma unroll 1
        for (int t = 0; t < unt; t += 2) {
            const bool last = (t == unt - 2);
            const char* a1 = cA + (size_t)(t + 1) * kstep;
            const char* a2 = last ? nA : cA + (size_t)(t + 2) * kstep; const char* b2 = last ? nB : cB + (size_t)(t + 2) * kstep;
            const char* a3 = a2 + kstep; const char* b3 = b2 + kstep;
            if (last && has_next) S.a_ready(nxt);
            PG8_LDB(B0, 0, 0); PG8_LDB(B1, 0, 1); PG8_SCHED; PG8_LDA(At, 0, 0); PG8_STAGE(PG8_SA(1, 1), a1 + hstepA, voffA);
            PG8_WAIT_V(8); PG8_WAIT_L(0); PG8_BAR; PG8_MMA(0, 0, At, B0); PG8_MMA(0, 1, At, B1); PG8_BAR; PG8_SCHED;
            PG8_LDA(At, 0, 1); PG8_STAGE(PG8_SB(0, 0), b2, voffB); PG8_STAGE(PG8_SB(0, 1), b2 + hstepB, voffB); PG8_STAGE(PG8_SA(0, 0), a2, voffA);
            PG8_WAIT_V(8); PG8_WAIT_L(0); PG8_BAR; PG8_MMA(1, 0, At, B0); PG8_MMA(1, 1, At, B1); PG8_BAR; PG8_SCHED;
            PG8_LDB(B0, 1, 0); PG8_LDB(B1, 1, 1); PG8_SCHED; PG8_LDA(At, 1, 0); PG8_STAGE(PG8_SA(0, 1), a2 + hstepA, voffA);
            PG8_WAIT_V(8); PG8_WAIT_L(0); PG8_BAR; PG8_MMA(0, 0, At, B0); PG8_MMA(0, 1, At, B1); PG8_BAR; PG8_SCHED;
            PG8_LDA(At, 1, 1); PG8_STAGE(PG8_SB(1, 0), b3, voffB); PG8_STAGE(PG8_SB(1, 1), b3 + hstepB, voffB); PG8_STAGE(PG8_SA(1, 0), a3, voffA);
            PG8_WAIT_V(8); PG8_WAIT_L(0); PG8_BAR; PG8_MMA(1, 0, At, B0); PG8_MMA(1, 1, At, B1); PG8_BAR; PG8_SCHED;
        }
        if constexpr (ALIGN_EPI) { if (wr == 0) PG8_BAR; }
        E(acc, cur, wr, wc, fr, fq); S.done(cur);
        if (!has_next) break;
#pragma unroll
        for (int a = 0; a < 2; ++a)
#pragma unroll
            for (int b = 0; b < 2; ++b)
#pragma unroll
                for (int m = 0; m < 4; ++m)
#pragma unroll
                    for (int n = 0; n < 2; ++n) acc[a][b][m][n] = (f32x4){0.f, 0.f, 0.f, 0.f};
        cur = nxt; cA = nA; cB = nB; ++ui;
        if constexpr (ALIGN_EPI) { if (wr == 1) PG8_BAR; }
    }
    PG8_WAIT_V(0);
    if constexpr (!ALIGN_EPI) { if (wr == 0) PG8_BAR; }
    PG8_BAR;
#undef PG8_SA
#undef PG8_SB
#undef PG8_STAGE
#undef PG8_LDA
#undef PG8_LDB
#undef PG8_MMA
#undef PG8_WAIT_V
#undef PG8_WAIT_L
#undef PG8_BAR
#undef PG8_SCHED
}
}

constexpr int NWAVES = 8, NTHREADS = 512;
constexpr int D = 2048, MP = 8192, MS = 1024, M = MP + MS;
constexpr int AW = 1024, EVEN_IN = 5120, DFF = 5632, PLE = 256;
constexpr int N_O1 = 7168, N_O2 = 8192;
constexpr float ALPHA = 1.6817928305074292f;
constexpr float LN_EPS = 1e-5f, GN_EPS = 64e-5f;
constexpr float SB_THRESH = 100.0f;

constexpr size_t OFF_YP = 0, OFF_YS = 16777216, OFF_KP = 18874368, OFF_VP = 35651584, OFF_WKVP = 52428800, OFF_SHP = 52690944, OFF_CVP = 52695040,
                 OFF_KS = 52740096, OFF_VS = 54837248, OFF_VAS = 56934400, OFF_WKVS = 59031552, OFF_SHS = 63225856, OFF_CVS = 63291392, OUT_END = 64012288;

enum { I_XP = 0, I_XS, I_CK, I_CV, I_WKV, I_SHIFT, I_CONV, I_PP, I_PS, I_EWIN, I_LNVG, I_LNVB, I_EWS, I_EBS, I_EWO, I_MU, I_CWR, I_CWK, I_CWV, I_CWO, I_W0, I_W1, I_W2,
       I_A0, I_A1, I_A2, I_V0, I_V1, I_V2, I_G1, I_G2, I_KK, I_KA, I_RK, I_GNG, I_GNB, I_FWIN, I_FCW, I_FCB, I_FWOUT, I_LN1G, I_LN1B, I_LN2G, I_LN2B, I_PLEP, I_PLEG, N_IN };

constexpr size_t MiB = 1u << 20;
constexpr size_t WS_CTL = 0, CTL_ZERO_BYTES = 1 * MiB;
constexpr size_t SZ_WIN = 5120ull * 2048 * 2, SZ_W22 = 2048ull * 2048 * 2, SZ_W1T = 7168ull * 2048 * 2, SZ_W2T = 8192ull * 256 * 2, SZ_FIN = 11264ull * 2048 * 2, SZ_FOUT = 2048ull * 5632 * 2, SZ_WP = 2048ull * 256 * 2;
constexpr size_t WS_WIN = 1 * MiB, WS_WOE = WS_WIN + 2 * SZ_WIN, WS_W1T = WS_WOE + 2 * SZ_W22, WS_W2T = WS_W1T + 2 * SZ_W1T, WS_WOC = WS_W2T + 2 * SZ_W2T,
                 WS_FIN = WS_WOC + 2 * SZ_W22, WS_FOUT = WS_FIN + 4 * SZ_FIN, WS_WG = WS_FOUT + 4 * SZ_FOUT, WS_WP = WS_WG + 4 * SZ_W22, WS_WEND = WS_WP + 4 * SZ_WP;
constexpr size_t SZ_X32 = (size_t)M * D * 4, SZ_X16 = (size_t)M * D * 2, SZ_PB = (size_t)M * PLE * 2, SZ_H16 = (size_t)M * 1024 * 2, SZ_FF16 = (size_t)M * DFF * 2, SZ_H1 = (size_t)M * 512 * 2;
constexpr size_t WS_X = WS_WEND, WS_XB = WS_X + SZ_X32, WS_Y = WS_XB + 2 * SZ_X16,
                 WS_PB = WS_Y + SZ_X32, WS_V1 = WS_PB + 4 * SZ_PB, WS_SCR = WS_V1 + SZ_X32;
constexpr size_t WS_U = WS_SCR, WS_ZV = WS_U + SZ_H16, WS_QF = WS_ZV + SZ_H16, WS_AO = WS_QF + 2 * SZ_H16, WS_EVEN_END = WS_AO + SZ_X16;
constexpr size_t WS_MIX = WS_SCR, WS_R = WS_MIX + 6 * SZ_X16, WS_K = WS_R + SZ_X32, WS_V3 = WS_K + SZ_X32, WS_H1 = WS_V3 + SZ_X32, WS_WD = WS_H1 + SZ_H1, WS_AA = WS_WD + SZ_X32,
                 WS_VG = WS_AA + SZ_X16, WS_GG = WS_VG + SZ_X16, WS_ODD_END = WS_GG + SZ_X16, WS_YS = WS_MIX, WS_YG = WS_MIX + SZ_X32;
constexpr size_t WS_SC = WS_WD;
static_assert(4608ull * 16384 <= SZ_X32, "chunk states fit the decay buffer");
constexpr size_t WS_CQ = WS_MIX + SZ_X32 + SZ_X16;
constexpr size_t SZ_SLAB = (size_t)MS * D * 4, WS_SLAB = WS_ODD_END;
constexpr size_t WS_HG = WS_SCR, WS_HU = WS_HG + SZ_FF16, WS_ACT = WS_HU + SZ_FF16, WS_PPF = WS_ACT + SZ_FF16, WS_FFN_END = WS_PPF + SZ_X32;
constexpr size_t WS_CRP = WS_SLAB + 7 * SZ_SLAB;
constexpr size_t WS_END = WS_CRP + 4608ull * 16384;
static_assert(WS_CQ + 4608ull * 16384 <= WS_R, "chunk Q inside the mixes");
static_assert(WS_FFN_END <= WS_SLAB && WS_EVEN_END <= WS_SLAB, "overlays below the slabs");
static_assert(WS_END <= 1568358400ull, "workspace map exceeds the guaranteed d_ws size");
constexpr int CW_BAR = 4096;

constexpr int LDS_BYTES = 147456;
constexpr int LDSCTL_OFF = LDS_BYTES - 256;

#define GAS __attribute__((address_space(1)))
#define LAS __attribute__((address_space(3)))
typedef unsigned short bf16;
typedef unsigned v4u __attribute__((ext_vector_type(4)));
typedef unsigned v2u __attribute__((ext_vector_type(2)));
typedef float f32x4 __attribute__((ext_vector_type(4)));
typedef float f32x2 __attribute__((ext_vector_type(2)));
#define LDS_WAIT() asm volatile("s_waitcnt lgkmcnt(0)" ::: "memory")
#define VM_WAIT() asm volatile("s_waitcnt vmcnt(0)" ::: "memory")
using pg8::cvt_pk_bf16;
__device__ __forceinline__ float bf_lo(unsigned w) { return __uint_as_float(w << 16); }
__device__ __forceinline__ float bf_hi(unsigned w) { return __uint_as_float(w & 0xffff0000u); }
__device__ __forceinline__ float sigmoid_f(float x) { return 1.f / (1.f + __expf(-x)); }
__device__ __forceinline__ float tanh_f(float x) { return 1.f - 2.f / (1.f + __expf(2.f * x)); }
__device__ __forceinline__ float gelu_f(float x) { const float u = 0.7978845608028654f * (x + 0.044715f * x * x * x); return x / (1.f + __expf(-2.f * u)); }
__device__ __forceinline__ f32x4 gelu4(f32x4 v) { return (f32x4){gelu_f(v.x), gelu_f(v.y), gelu_f(v.z), gelu_f(v.w)}; }
__device__ __forceinline__ v2u pk4(f32x4 v) { v2u r; r.x = cvt_pk_bf16(v.x, v.y); r.y = cvt_pk_bf16(v.z, v.w); return r; }
__device__ __forceinline__ float fma_s(float a, float b, float c) { float r; asm("v_fma_f32 %0, %1, %2, %3" : "=v"(r) : "v"(a), "v"(b), "v"(c)); return r; }
__device__ __forceinline__ float mul_s(float a, float b) { float r; asm("v_mul_f32_e32 %0, %1, %2" : "=v"(r) : "v"(a), "v"(b)); return r; }
template <int CTRL> __device__ __forceinline__ float dpp_f(float x) { return __builtin_bit_cast(float, __builtin_amdgcn_update_dpp(0, __builtin_bit_cast(int, x), CTRL, 0xF, 0xF, true)); }
__device__ __forceinline__ float reduce8(float x) { x += dpp_f<0xB1>(x); x += dpp_f<0x4E>(x); x += dpp_f<0x141>(x); return x; }
__device__ __forceinline__ float reduce16(float x) { x = reduce8(x); x += dpp_f<0x140>(x); return x; }
__device__ __forceinline__ float wave_sum(float x) { x = reduce16(x); x += __shfl_xor(x, 16); x += __shfl_xor(x, 32); return x; }

#define XLAS LAS
#define XB_TMO      128
#define XB_XCNT(j)  (256  + 64 * (j))
#define XB_XSUB(j)  (1280 + 64 * (j))
#define XB_XGEN(j)  (2304 + 64 * (j))
#define XB_TOP      3328
#define XB_TOPGEN   3392
#define XCD_BAR_WORDS 3456
#define XB_SPIN_CAP (1u << 18)
__device__ __forceinline__ unsigned xb_ld(unsigned* p)              { return __hip_atomic_load(p, __ATOMIC_RELAXED, __HIP_MEMORY_SCOPE_AGENT); }
__device__ __forceinline__ unsigned xb_add(unsigned* p, unsigned v) { return __hip_atomic_fetch_add(p, v, __ATOMIC_RELAXED, __HIP_MEMORY_SCOPE_AGENT); }
__device__ __forceinline__ unsigned xb_xcc_id() { return (unsigned)__builtin_amdgcn_s_getreg((3 << 11) | 20) & 0xFu; }
#define XB_SPIN(cond, bar) do { unsigned _sp = 0; while (cond) { __builtin_amdgcn_s_sleep(1); \
    if ((++_sp & 255u) == 0u) { if (xb_ld(&(bar)[XB_TMO])) break; if (_sp > XB_SPIN_CAP) { atomicAdd(&(bar)[XB_TMO], 1u); break; } } } } while (0)
struct XcdBarrier { unsigned* bar; unsigned x; volatile LAS unsigned* st; };
__device__ __forceinline__ XcdBarrier xcd_barrier_post(unsigned* bar, volatile LAS unsigned* st) {
    XcdBarrier b; b.bar = bar; b.x = xb_xcc_id(); b.st = st;
    if (threadIdx.x == 0) (void)xb_add(&bar[XB_XCNT(b.x)], 1u);
    return b;
}
__device__ __forceinline__ void xcd_barrier_complete(unsigned* bar, unsigned x, unsigned& nloc, unsigned& nx) {
    const unsigned G = gridDim.x * gridDim.y * gridDim.z;
    unsigned sum, cnt, mine, sp = 0u;
    for (;;) {
        sum = 0u; cnt = 0u; mine = 0u;
#pragma unroll
        for (unsigned j = 0; j < 16; ++j) { const unsigned c = xb_ld(&bar[XB_XCNT(j)]); sum += c; cnt += (c > 0u) ? 1u : 0u; mine = (j == x) ? c : mine; }
        if (sum == G) break;
        __builtin_amdgcn_s_sleep(1);
        if ((++sp & 255u) == 0u) { if (xb_ld(&bar[XB_TMO])) break; if (sp > XB_SPIN_CAP) { atomicAdd(&bar[XB_TMO], 1u); break; } }
    }
    nloc = mine > 0u ? mine : 1u; nx = cnt > 0u ? cnt : 1u;
}
__device__ __forceinline__ void xcd_barrier(const XcdBarrier& b) {
    asm volatile("s_waitcnt vmcnt(0)" ::: "memory");
    __syncthreads();
    if (threadIdx.x == 0) {
        unsigned* bar = b.bar;
        __builtin_amdgcn_s_waitcnt(0);
        unsigned nloc = b.st[0], nx = b.st[1];
        if (nloc == 0u) { xcd_barrier_complete(bar, b.x, nloc, nx); b.st[0] = nloc; b.st[1] = nx; }
        const unsigned old = xb_add(&bar[XB_XSUB(b.x)], 1u);
        const unsigned gen = old / nloc;
        if (old + 1u == (gen + 1u) * nloc) {
            __builtin_amdgcn_fence(__ATOMIC_RELEASE, "agent");
            asm volatile("s_waitcnt vmcnt(0)" ::: "memory");
            const unsigned og = xb_add(&bar[XB_TOP], 1u);
            const unsigned tg = og / nx;
            if (og + 1u == (tg + 1u) * nx) xb_add(&bar[XB_TOPGEN], 1u);
            else XB_SPIN(xb_ld(&bar[XB_TOPGEN]) == tg, bar);
            __builtin_amdgcn_fence(__ATOMIC_ACQUIRE, "agent");
            xb_add(&bar[XB_XGEN(b.x)], 1u);
            asm volatile("s_waitcnt vmcnt(0)" ::: "memory");
        } else {
            XB_SPIN(xb_ld(&bar[XB_XGEN(b.x)]) == gen, bar);
            __builtin_amdgcn_fence(__ATOMIC_ACQUIRE, "agent");
            asm volatile("s_waitcnt vmcnt(0)" ::: "memory");
        }
    }
    __syncthreads();
}

struct Args { const float* in[N_IN]; float* out; unsigned char* ws; int ph_lo, ph_hi; };

__device__ __forceinline__ const float* inp(const Args& a, int i) { int k = i; asm volatile("" : "+s"(k)); return a.in[k]; }
__device__ __forceinline__ unsigned char* wsp(const Args& a) { size_t z = 0; asm volatile("" : "+s"(z)); return a.ws + z; }
__device__ __forceinline__ float* outp(const Args& a) { size_t z = 0; asm volatile("" : "+s"(z)); return a.out + z; }

__device__ __forceinline__ bool seq_start(int m) { return m == 0 || (m >= MP && ((m - MP) & 63) == 0); }

template <class F> __device__ __forceinline__ void epi_each(const f32x4 (&acc)[2][2][4][2], const pg8::Unit& u, int wr, int wc, int fr, int fq, F&& f) {
#pragma unroll
    for (int ai = 0; ai < 2; ++ai)
#pragma unroll
        for (int m = 0; m < 4; ++m) { const int row = u.pm * 256 + ai * 128 + wr * 64 + m * 16 + fr;
#pragma unroll
            for (int bj = 0; bj < 2; ++bj)
#pragma unroll
                for (int n = 0; n < 2; ++n) f(row, u.pn * 256 + bj * 128 + wc * 32 + n * 16 + fq * 4, acc[ai][bj][m][n]);
            asm volatile("" ::: "memory"); }
}
template <class F> __device__ __forceinline__ void epi_each8(const f32x4 (&acc)[2][2][4][2], const pg8::Unit& u, int wr, int wc, int fr, int fq, F&& f) {
#pragma unroll
    for (int ai = 0; ai < 2; ++ai)
#pragma unroll
        for (int m = 0; m < 4; ++m) { const int row = u.pm * 256 + ai * 128 + wr * 64 + m * 16 + fr;
#pragma unroll
            for (int bj = 0; bj < 2; ++bj) f(row, u.pn * 256 + bj * 128 + wc * 32 + fq * 8, acc[ai][bj][m][0], acc[ai][bj][m][1]);
            asm volatile("" ::: "memory"); }
}

__device__ __forceinline__ v4u pk8(f32x4 a, f32x4 b) { v4u w; w.x = cvt_pk_bf16(a.x, a.y); w.y = cvt_pk_bf16(a.z, a.w); w.z = cvt_pk_bf16(b.x, b.y); w.w = cvt_pk_bf16(b.z, b.w); return w; }
struct EpiEvenIn {
    static constexpr bool PERM = true;
    bf16* U; bf16* ZV; float* QF; float* out; int j;
    __device__ __forceinline__ void operator()(const f32x4 (&acc)[2][2][4][2], const pg8::Unit& u, int wr, int wc, int fr, int fq) const {
        const int grp = u.pn >> 2;
        if (grp == 0) epi_each8(acc, u, wr, wc, fr, fq, [&](int row, int col, f32x4 v0, f32x4 v1) { *(v4u*)(U + (size_t)row * 1024 + col) = pk8(gelu4(v0), gelu4(v1)); });
        else if (grp == 1) epi_each8(acc, u, wr, wc, fr, fq, [&](int row, int col, f32x4 v0, f32x4 v1) { *(v4u*)(ZV + (size_t)row * 1024 + (col - 1024)) = pk8(gelu4(v0), gelu4(v1)); });
        else if (grp == 2) epi_each8(acc, u, wr, wc, fr, fq, [&](int row, int col, f32x4 v0, f32x4 v1) { float* d = QF + (size_t)row * 1024 + (col - 2048); *(f32x4*)d = v0; *(f32x4*)(d + 4) = v1; });
        else { float* bp = out + (grp == 3 ? OFF_KP : OFF_VP) + (size_t)j * MP * 1024; float* bs = out + (grp == 3 ? OFF_KS : OFF_VS) + (size_t)j * MS * 1024; const int c0 = grp == 3 ? 3072 : 4096;
            epi_each8(acc, u, wr, wc, fr, fq, [&](int row, int col, f32x4 v0, f32x4 v1) { float* d = (row < MP ? bp + (size_t)row * 1024 : bs + (size_t)(row - MP) * 1024) + (col - c0); *(f32x4*)d = v0; *(f32x4*)(d + 4) = v1; }); }
    }
};
struct EpiResid {
    static constexpr bool PERM = true;
    const float* X; float* Y; float* SL;
    __device__ __forceinline__ void operator()(const f32x4 (&acc)[2][2][4][2], const pg8::Unit& u, int wr, int wc, int fr, int fq) const {
        if (u.sp == 0) epi_each8(acc, u, wr, wc, fr, fq, [&](int row, int col, f32x4 v0, f32x4 v1) { const size_t o = (size_t)row * D + col; const f32x4 x0 = *(const f32x4*)(X + o), x1 = *(const f32x4*)(X + o + 4); *(f32x4*)(Y + o) = x0 * ALPHA + v0; *(f32x4*)(Y + o + 4) = x1 * ALPHA + v1; });
        else { float* sl = SL + (size_t)(u.sp - 1) * MS * D; epi_each8(acc, u, wr, wc, fr, fq, [&](int row, int col, f32x4 v0, f32x4 v1) { float* d = sl + (size_t)(row - MP) * D + col; *(f32x4*)d = v0; *(f32x4*)(d + 4) = v1; }); }
    }
};
struct EpiFfnIn {
    static constexpr bool PERM = true;
    bf16* HG; bf16* HU; float* out; int layer;
    __device__ __forceinline__ void operator()(const f32x4 (&acc)[2][2][4][2], const pg8::Unit& u, int wr, int wc, int fr, int fq) const {
        if (u.pn < 22) { float* cp = out + OFF_CVP + (size_t)layer * 2 * DFF; float* cs = out + OFF_CVS + (size_t)layer * 16 * 2 * DFF;
            epi_each8(acc, u, wr, wc, fr, fq, [&](int row, int col, f32x4 v0, f32x4 v1) {
                v4u w; w.x = cvt_pk_bf16(v0.x, v0.y); w.y = cvt_pk_bf16(v0.z, v0.w); w.z = cvt_pk_bf16(v1.x, v1.y); w.w = cvt_pk_bf16(v1.z, v1.w);
                *(v4u*)(HG + (size_t)row * DFF + col) = w;
                float* d = nullptr;
                if (row < MP) { if (row >= MP - 2) d = cp + (size_t)(row - (MP - 2)) * DFF; }
                else { const int t = (row - MP) & 63, b = (row - MP) >> 6; if (t >= 62) d = cs + ((size_t)b * 2 + (t - 62)) * DFF; }
                if (d) { *(f32x4*)(d + col) = v0; *(f32x4*)(d + col + 4) = v1; } }); }
        else epi_each8(acc, u, wr, wc, fr, fq, [&](int row, int col, f32x4 v0, f32x4 v1) {
                v4u w; w.x = cvt_pk_bf16(v0.x, v0.y); w.y = cvt_pk_bf16(v0.z, v0.w); w.z = cvt_pk_bf16(v1.x, v1.y); w.w = cvt_pk_bf16(v1.z, v1.w);
                *(v4u*)(HU + (size_t)row * DFF + (col - DFF)) = w; });
    }
};
struct EpiF32 {
    static constexpr bool PERM = true;
    float* C; int ldc;
    __device__ __forceinline__ void operator()(const f32x4 (&acc)[2][2][4][2], const pg8::Unit& u, int wr, int wc, int fr, int fq) const {
        epi_each8(acc, u, wr, wc, fr, fq, [&](int row, int col, f32x4 v0, f32x4 v1) { float* d = C + (size_t)row * ldc + col; *(f32x4*)d = v0; *(f32x4*)(d + 4) = v1; });
    }
};
struct EpiPle {
    static constexpr bool PERM = true;
    float* X; bf16* XB; const float* PPF; float* yout;
    __device__ __forceinline__ void operator()(const f32x4 (&acc)[2][2][4][2], const pg8::Unit& u, int wr, int wc, int fr, int fq) const {
        epi_each8(acc, u, wr, wc, fr, fq, [&](int row, int col, f32x4 v0, f32x4 v1) { const size_t o = (size_t)row * D + col; const f32x4 x0 = *(const f32x4*)(X + o), x1 = *(const f32x4*)(X + o + 4), p0 = *(const f32x4*)(PPF + o), p1 = *(const f32x4*)(PPF + o + 4);
            f32x4 r0, r1; r0.x = x0.x + sigmoid_f(v0.x) * p0.x; r0.y = x0.y + sigmoid_f(v0.y) * p0.y; r0.z = x0.z + sigmoid_f(v0.z) * p0.z; r0.w = x0.w + sigmoid_f(v0.w) * p0.w;
            r1.x = x1.x + sigmoid_f(v1.x) * p1.x; r1.y = x1.y + sigmoid_f(v1.y) * p1.y; r1.z = x1.z + sigmoid_f(v1.z) * p1.z; r1.w = x1.w + sigmoid_f(v1.w) * p1.w;
            *(f32x4*)(X + o) = r0; *(f32x4*)(X + o + 4) = r1; *(v4u*)(XB + o) = pk8(r0, r1); if (yout) { *(f32x4*)(yout + o) = r0; *(f32x4*)(yout + o + 4) = r1; } });
    }
};
struct EpiO1 {
    static constexpr bool PERM = true;
    float* R; float* K; float* V; bf16* H1;
    __device__ __forceinline__ void operator()(const f32x4 (&acc)[2][2][4][2], const pg8::Unit& u, int wr, int wc, int fr, int fq) const {
        const int pn = u.pn;
        if (pn < 8) epi_each8(acc, u, wr, wc, fr, fq, [&](int row, int col, f32x4 v0, f32x4 v1) { float* d = R + (size_t)row * D + col; *(f32x4*)d = v0; *(f32x4*)(d + 4) = v1; });
        else if (pn < 16) epi_each8(acc, u, wr, wc, fr, fq, [&](int row, int col, f32x4 v0, f32x4 v1) { float* d = K + (size_t)row * D + (col - 2048); *(f32x4*)d = v0; *(f32x4*)(d + 4) = v1; });
        else if (pn < 24) epi_each8(acc, u, wr, wc, fr, fq, [&](int row, int col, f32x4 v0, f32x4 v1) { float* d = V + (size_t)row * D + (col - 4096); *(f32x4*)d = v0; *(f32x4*)(d + 4) = v1; });
        else {
            const int t = pn - 24; const int lim = t == 3 ? 256 : (t == 2 ? 64 : 96), off = t == 3 ? 256 : 96 * t; const bool ident = (t == 1 || t == 2); const float c1 = t == 0 ? -2.f : -1.f, m = t == 0 ? 2.f : 1.f, ad = t == 0 ? -1.f : 0.f;
            epi_each8(acc, u, wr, wc, fr, fq, [&](int row, int col, f32x4 v0, f32x4 v1) { const int lc = col - pn * 256; if (lc < lim) { f32x4 o0 = v0, o1 = v1;
                if (!ident) { o0.x = m / (1.f + __expf(c1 * v0.x)) + ad; o0.y = m / (1.f + __expf(c1 * v0.y)) + ad; o0.z = m / (1.f + __expf(c1 * v0.z)) + ad; o0.w = m / (1.f + __expf(c1 * v0.w)) + ad;
                              o1.x = m / (1.f + __expf(c1 * v1.x)) + ad; o1.y = m / (1.f + __expf(c1 * v1.y)) + ad; o1.z = m / (1.f + __expf(c1 * v1.z)) + ad; o1.w = m / (1.f + __expf(c1 * v1.w)) + ad; }
                *(v4u*)(H1 + (size_t)row * 512 + off + lc) = pk8(o0, o1); } }); }
    }
};
__device__ __forceinline__ f32x4 sig4(f32x4 b, f32x4 v) { return (f32x4){sigmoid_f(b.x + v.x), sigmoid_f(b.y + v.y), sigmoid_f(b.z + v.z), sigmoid_f(b.w + v.w)}; }
struct EpiO2 {
    static constexpr bool PERM = true;
    float* WD; bf16* AA; bf16* VG; bf16* GG; const float* w0; const float* a0; const float* v0;
    __device__ __forceinline__ void operator()(const f32x4 (&acc)[2][2][4][2], const pg8::Unit& u, int wr, int wc, int fr, int fq) const {
        const int grp = u.pn >> 3;
        if (grp == 0) epi_each8(acc, u, wr, wc, fr, fq, [&](int row, int col, f32x4 x0, f32x4 x1) { const f32x4 b0 = *(const f32x4*)(w0 + col), b1 = *(const f32x4*)(w0 + col + 4);
            float* d = WD + (size_t)row * D + col; *(f32x4*)d = sig4(b0, x0) * -0.6065306597126334f; *(f32x4*)(d + 4) = sig4(b1, x1) * -0.6065306597126334f; });
        else if (grp == 1) epi_each8(acc, u, wr, wc, fr, fq, [&](int row, int col, f32x4 x0, f32x4 x1) { const int c = col - 2048; const f32x4 b0 = *(const f32x4*)(a0 + c), b1 = *(const f32x4*)(a0 + c + 4);
            *(v4u*)(AA + (size_t)row * D + c) = pk8(sig4(b0, x0), sig4(b1, x1)); });
        else if (grp == 2) { if (v0) epi_each8(acc, u, wr, wc, fr, fq, [&](int row, int col, f32x4 x0, f32x4 x1) { const int c = col - 4096; const f32x4 b0 = *(const f32x4*)(v0 + c), b1 = *(const f32x4*)(v0 + c + 4);
            *(v4u*)(VG + (size_t)row * D + c) = pk8(sig4(b0, x0), sig4(b1, x1)); }); }
        else epi_each8(acc, u, wr, wc, fr, fq, [&](int row, int col, f32x4 x0, f32x4 x1) { const int c = col - 6144; *(v4u*)(GG + (size_t)row * D + c) = pk8(x0, x1); });
    }
};

struct Ctx { int tid, lane, wave, gw, NGW, gtid, NT; LAS unsigned char* lds; };
__device__ __forceinline__ Ctx make_ctx(LAS unsigned char* lds) { Ctx c; int t = threadIdx.x; asm volatile("" : "+v"(t)); c.tid = t; c.lane = t & 63; c.wave = __builtin_amdgcn_readfirstlane(t >> 6); c.lds = lds;
    c.gw = blockIdx.x * NWAVES + c.wave; c.NGW = gridDim.x * NWAVES; c.gtid = blockIdx.x * NTHREADS + t; c.NT = gridDim.x * NTHREADS; return c; }

struct TJD { int src_idx; unsigned long long src_off, dst_off; int K, N, row_off; };
#define TJ_ODD(j)  {I_EWIN, (unsigned long long)(j) * 2048 * 5120, WS_WIN + (j) * SZ_WIN, 2048, 5120, 0}, {I_EWO, (unsigned long long)(j) * 2048 * 2048, WS_WOE + (j) * SZ_W22, 2048, 2048, 0}, \
    {I_CWR, (unsigned long long)(j) * 2048 * 2048, WS_W1T + (j) * SZ_W1T, 2048, 2048, 0}, {I_CWK, (unsigned long long)(j) * 2048 * 2048, WS_W1T + (j) * SZ_W1T, 2048, 2048, 2048}, {I_CWV, (unsigned long long)(j) * 2048 * 2048, WS_W1T + (j) * SZ_W1T, 2048, 2048, 4096}, \
    {I_W1, (unsigned long long)(j) * 2048 * 96, WS_W1T + (j) * SZ_W1T, 2048, 96, 6144}, {I_A1, (unsigned long long)(j) * 2048 * 96, WS_W1T + (j) * SZ_W1T, 2048, 96, 6400}, {I_G1, (unsigned long long)(j) * 2048 * 256, WS_W1T + (j) * SZ_W1T, 2048, 256, 6912}, \
    {I_CWO, (unsigned long long)(j) * 2048 * 2048, WS_WOC + (j) * SZ_W22, 2048, 2048, 0}
#define TJ_FFN(i)  {I_FWIN, (unsigned long long)(i) * 2048 * 11264, WS_FIN + (i) * SZ_FIN, 2048, 11264, 0}, {I_FWOUT, (unsigned long long)(i) * 5632 * 2048, WS_FOUT + (i) * SZ_FOUT, 5632, 2048, 0}, \
    {I_PLEG, (unsigned long long)(i) * 2048 * 2048, WS_WG + (i) * SZ_W22, 2048, 2048, 0}, {I_PLEP, (unsigned long long)(i) * 256 * 2048, WS_WP + (i) * SZ_WP, 256, 2048, 0}
__device__ const TJD tj_table[35] = { TJ_ODD(0), TJ_ODD(1), {I_V1, 0ull, WS_W1T + 1 * SZ_W1T, 2048, 64, 6656}, TJ_FFN(0), TJ_FFN(1), TJ_FFN(2), TJ_FFN(3) };
constexpr int N_TJOBS = 35;
__device__ __forceinline__ void transpose_item(const float* W, int K, int N, bf16* WT, int row_off, LAS float* scr, int item, int lane) {
    const int nblk = N / 32, kb = item / nblk, nb = item % nblk, k0 = 64 * kb, n0 = 32 * nb;
#pragma unroll 8
    for (int i = 0; i < 32; ++i) { const int kk = 2 * i + (lane >> 5); scr[kk * 33 + (lane & 31)] = W[(size_t)(k0 + kk) * N + n0 + (lane & 31)]; }
    LDS_WAIT(); asm volatile("" ::: "memory");
    const int c = lane & 7;
#pragma unroll
    for (int j = 0; j < 4; ++j) { const int n = (lane >> 3) + 8 * j; const LAS float* s = scr + (8 * c) * 33 + n;
        v4u o; o.x = cvt_pk_bf16(s[0 * 33], s[1 * 33]); o.y = cvt_pk_bf16(s[2 * 33], s[3 * 33]); o.z = cvt_pk_bf16(s[4 * 33], s[5 * 33]); o.w = cvt_pk_bf16(s[6 * 33], s[7 * 33]);
        *(v4u*)(WT + (size_t)(row_off + n0 + n) * K + k0 + 8 * c) = o; }
    LDS_WAIT(); asm volatile("" ::: "memory");
}
__device__ __forceinline__ void p0_prologue(const Args& a, const Ctx& c) {
    LAS float* scr = (LAS float*)(c.lds + c.wave * 16384);
    for (int job = 0; job < N_TJOBS; ++job) { const TJD t = tj_table[job]; const int nit = (t.K / 64) * (t.N / 32); const float* src = a.in[t.src_idx] + t.src_off; bf16* dst = (bf16*)(wsp(a) + t.dst_off);
        for (int it = c.gw; it < nit; it += c.NGW) transpose_item(src, t.K, t.N, dst, t.row_off, scr, it, c.lane); }
    const float* pw2 = inp(a, I_W2); const float* pa2 = inp(a, I_A2); const float* pv2 = inp(a, I_V2); const float* pg2 = inp(a, I_G2);
    for (int idx = c.gtid; idx < 2 * 8192 * 32; idx += c.NT) { const int j = idx / (8192 * 32), r = idx % (8192 * 32), k8 = r / 8192, n = r % 8192, k0 = k8 * 8;
        float v[8];
#pragma unroll
        for (int e = 0; e < 8; ++e) { const int k = k0 + e; float x = 0.f;
            if (n < 2048) { if (k < 96) x = pw2[((size_t)j * 96 + k) * 2048 + n]; }
            else if (n < 4096) { if (k >= 96 && k < 192) x = pa2[((size_t)j * 96 + (k - 96)) * 2048 + (n - 2048)]; }
            else if (n < 6144) { if (j == 1 && k >= 192) x = pv2[(size_t)(k - 192) * 2048 + (n - 4096)]; }
            else x = pg2[((size_t)j * 256 + k) * 2048 + (n - 6144)];
            v[e] = x; }
        v4u o; o.x = cvt_pk_bf16(v[0], v[1]); o.y = cvt_pk_bf16(v[2], v[3]); o.z = cvt_pk_bf16(v[4], v[5]); o.w = cvt_pk_bf16(v[6], v[7]);
        *(v4u*)((bf16*)(wsp(a) + WS_W2T + j * SZ_W2T) + (size_t)n * 256 + k0) = o; }
    float* X = (float*)(wsp(a) + WS_X); bf16* XB = (bf16*)(wsp(a) + WS_XB);
    const float* pxp = inp(a, I_XP); const float* pxs = inp(a, I_XS);
    for (int m = c.gw; m < M; m += c.NGW) { const float* src = m < MP ? pxp + (size_t)m * D : pxs + (size_t)(m - MP) * D;
#pragma unroll
        for (int q = 0; q < 8; ++q) { const int col = (c.lane + 64 * q) * 4; const f32x4 v = *(const f32x4*)(src + col); *(f32x4*)(X + (size_t)m * D + col) = v; *(v2u*)(XB + (size_t)m * D + col) = pk4(v); } }
    bf16* PB = (bf16*)(wsp(a) + WS_PB);
    const float* ppp = inp(a, I_PP); const float* pps = inp(a, I_PS);
    for (int idx = c.gtid; idx < 4 * M * 32; idx += c.NT) { const int i = idx / (M * 32), r = idx % (M * 32), m = r / 32, c8 = (r % 32) * 8;
        const float* src = m < MP ? ppp + ((size_t)i * MP + m) * PLE + c8 : pps + ((size_t)i * MS + (m - MP)) * PLE + c8;
        const f32x4 v0 = *(const f32x4*)src, v1 = *(const f32x4*)(src + 4);
        v4u o; o.x = cvt_pk_bf16(v0.x, v0.y); o.y = cvt_pk_bf16(v0.z, v0.w); o.z = cvt_pk_bf16(v1.x, v1.y); o.w = cvt_pk_bf16(v1.z, v1.w);
        *(v4u*)(PB + ((size_t)i * M + m) * PLE + c8) = o; }
}

__device__ __forceinline__ void ln_phase(const float* Y, const float* SL, const float* g, const float* b, float* X, bf16* XB, const Ctx& c) {
    for (int m = c.gw; m < M; m += c.NGW) {
        const f32x4* yr = (const f32x4*)(Y + (size_t)m * D) + c.lane; f32x4 v[8]; float s = 0.f;
#pragma unroll
        for (int q = 0; q < 8; ++q) v[q] = yr[64 * q];
        if (m >= MP) {
#pragma unroll 1
            for (int sp = 0; sp < 7; ++sp) { const f32x4* pr = (const f32x4*)(SL + ((size_t)sp * MS + (m - MP)) * D) + c.lane;
#pragma unroll
                for (int q = 0; q < 8; ++q) v[q] += pr[64 * q]; } }
#pragma unroll
        for (int q = 0; q < 8; ++q) s += (v[q].x + v[q].y) + (v[q].z + v[q].w);
        const float mean = wave_sum(s) * (1.f / D); float s2 = 0.f;
#pragma unroll
        for (int q = 0; q < 8; ++q) { v[q] = v[q] - mean; s2 += (v[q].x * v[q].x + v[q].y * v[q].y) + (v[q].z * v[q].z + v[q].w * v[q].w); }
        const float rstd = 1.f / sqrtf(wave_sum(s2) * (1.f / D) + LN_EPS);
#pragma unroll
        for (int q = 0; q < 8; ++q) { const int col = (c.lane + 64 * q) * 4; const f32x4 g4 = *(const f32x4*)(g + col), b4 = *(const f32x4*)(b + col); const f32x4 o = v[q] * rstd * g4 + b4;
            *(f32x4*)(X + (size_t)m * D + col) = o; *(v2u*)(XB + (size_t)m * D + col) = pk4(o); }
    }
}

__device__ __forceinline__ void mix_phase(const Args& a, int j, const Ctx& c) {
    const float* X = (const float*)(wsp(a) + WS_X); bf16* MIX = (bf16*)(wsp(a) + WS_MIX); const float* mu = inp(a, I_MU) + (size_t)j * 6 * D; const float* shin = inp(a, I_SHIFT);
    for (int m = c.gw; m < M; m += c.NGW) {
        const float* xr = X + (size_t)m * D; const float* xp = xr - D; bool zero_prev = false;
        if (seq_start(m)) { if (m == 0) zero_prev = true; else xp = shin + ((size_t)j * 16 + ((m - MP) >> 6)) * D; }
        float* sh = nullptr;
        if (m == MP - 1) sh = outp(a) + OFF_SHP + (size_t)j * D; else if (m >= MP && ((m - MP) & 63) == 63) sh = outp(a) + OFF_SHS + ((size_t)j * 16 + ((m - MP) >> 6)) * D;
#pragma unroll
        for (int q = 0; q < 8; ++q) { const int col = (c.lane + 64 * q) * 4; const f32x4 x = *(const f32x4*)(xr + col); f32x4 p = (f32x4){0.f, 0.f, 0.f, 0.f}; if (!zero_prev) p = *(const f32x4*)(xp + col);
            const f32x4 dx = p - x;
#pragma unroll
            for (int s = 0; s < 6; ++s) { const f32x4 mu4 = *(const f32x4*)(mu + s * D + col); *(v2u*)(MIX + ((size_t)s * M + m) * D + col) = pk4(x + dx * mu4); }
            if (sh) *(f32x4*)(sh + col) = x; }
    }
}

__device__ __forceinline__ void unpack8(v4u w, float (&f)[8]) { f[0] = bf_lo(w.x); f[1] = bf_hi(w.x); f[2] = bf_lo(w.y); f[3] = bf_hi(w.y); f[4] = bf_lo(w.z); f[5] = bf_hi(w.z); f[6] = bf_lo(w.w); f[7] = bf_hi(w.w); }
__device__ __forceinline__ void load8f(const float* p, float (&f)[8]) { const f32x4 a = *(const f32x4*)p, b = *(const f32x4*)(p + 4); f[0] = a.x; f[1] = a.y; f[2] = a.z; f[3] = a.w; f[4] = b.x; f[5] = b.y; f[6] = b.z; f[7] = b.w; }
__device__ __forceinline__ void act_phase(const Args& a, int layer, const Ctx& c) {
    const bf16* HG = (const bf16*)(wsp(a) + WS_HG); const bf16* HU = (const bf16*)(wsp(a) + WS_HU); bf16* ACT = (bf16*)(wsp(a) + WS_ACT);
    const float* cw = inp(a, I_FCW) + (size_t)layer * 3 * DFF; const float* cb = inp(a, I_FCB) + (size_t)layer * DFF; const float* cst = inp(a, I_CONV);
    constexpr int C8 = DFF / 8;
    for (int idx = c.gtid; idx < (M / 8) * C8; idx += c.NT) { const int rb = idx / C8, col = (idx % C8) * 8, row0 = rb * 8;
        const int t0 = row0 < MP ? row0 : ((row0 - MP) & 63); const float* cprev = row0 < MP ? nullptr : cst + (((size_t)layer * 16 + ((row0 - MP) >> 6)) * 2) * DFF;
        float w0[8], w1[8], w2[8], bb[8], hm2[8], hm1[8];
        load8f(cw + col, w0); load8f(cw + DFF + col, w1); load8f(cw + 2 * DFF + col, w2); load8f(cb + col, bb);
        if (t0 >= 2) { unpack8(*(const v4u*)(HG + (size_t)(row0 - 2) * DFF + col), hm2); unpack8(*(const v4u*)(HG + (size_t)(row0 - 1) * DFF + col), hm1); }
        else if (cprev) { load8f(cprev + col, hm2); load8f(cprev + DFF + col, hm1); }
        else {
#pragma unroll
            for (int e = 0; e < 8; ++e) { hm2[e] = 0.f; hm1[e] = 0.f; } }
        v4u hgv[8], huv[8];
#pragma unroll
        for (int rr = 0; rr < 8; ++rr) { hgv[rr] = *(const v4u*)(HG + (size_t)(row0 + rr) * DFF + col); huv[rr] = *(const v4u*)(HU + (size_t)(row0 + rr) * DFF + col); }
#pragma unroll
        for (int rr = 0; rr < 8; ++rr) { float h[8], hu[8], o[8]; unpack8(hgv[rr], h); unpack8(huv[rr], hu);
#pragma unroll
            for (int e = 0; e < 8; ++e) { const float hc = bb[e] + hm2[e] * w0[e] + hm1[e] * w1[e] + h[e] * w2[e]; o[e] = gelu_f(hc) * hu[e]; hm2[e] = hm1[e]; hm1[e] = h[e]; }
            v4u w; w.x = cvt_pk_bf16(o[0], o[1]); w.y = cvt_pk_bf16(o[2], o[3]); w.z = cvt_pk_bf16(o[4], o[5]); w.w = cvt_pk_bf16(o[6], o[7]);
            *(v4u*)(ACT + (size_t)(row0 + rr) * DFF + col) = w; }
    }
}

__device__ __forceinline__ void spatial_task(const Args& a, int j, int row0, int n, int h, const Ctx& c) {
    LAS float* vn = (LAS float*)c.lds;
    LAS float* Wl = vn + 128 * 128;
    LAS float* st = Wl + 128 * 132;
    const bf16* ZV = (const bf16*)(wsp(a) + WS_ZV); const bf16* U = (const bf16*)(wsp(a) + WS_U); bf16* AO = (bf16*)(wsp(a) + WS_AO);
    const float* lg = inp(a, I_LNVG) + (size_t)j * AW; const float* lb = inp(a, I_LNVB) + (size_t)j * AW;
    const float* Wg = inp(a, I_EWS) + ((size_t)j * 8 + h) * 128 * 128; const float* bs = inp(a, I_EBS) + ((size_t)j * 8 + h) * 128;
    for (int rr = 0; rr < 16; ++rr) { const int r = c.wave * 16 + rr; if (r < n) {
        const v4u* zr = (const v4u*)(ZV + (size_t)(row0 + r) * AW) + c.lane * 2; float f[16]; { float t8[8]; unpack8(zr[0], t8);
#pragma unroll
            for (int e = 0; e < 8; ++e) f[e] = t8[e]; unpack8(zr[1], t8);
#pragma unroll
            for (int e = 0; e < 8; ++e) f[8 + e] = t8[e]; }
        float s = 0.f;
#pragma unroll
        for (int e = 0; e < 16; ++e) s += f[e];
        const float mean = wave_sum(s) * (1.f / AW); float s2 = 0.f;
#pragma unroll
        for (int e = 0; e < 16; ++e) { const float d = f[e] - mean; s2 += d * d; }
        const float rstd = 1.f / sqrtf(wave_sum(s2) * (1.f / AW) + LN_EPS);
        if (c.lane == 0) { st[r * 2] = mean; st[r * 2 + 1] = rstd; } } }
    for (int k = 0; k < 32; ++k) { const int idx = c.tid + k * NTHREADS, t = idx >> 7, s = idx & 127; Wl[t * 132 + s] = Wg[idx]; }
    __syncthreads();
    float* vaout = (row0 >= MP) ? outp(a) + OFF_VAS + (size_t)j * MS * AW + (size_t)(row0 - MP) * AW + h * 128 : nullptr;
    for (int k = 0; k < 32; ++k) { const int idx = c.tid + k * NTHREADS, s = idx >> 7, cc = idx & 127;
        if (s < n) { const float z = __uint_as_float((unsigned)ZV[(size_t)(row0 + s) * AW + h * 128 + cc] << 16);
            const float v = (z - st[s * 2]) * st[s * 2 + 1] * lg[h * 128 + cc] + lb[h * 128 + cc]; vn[s * 128 + cc] = v; if (vaout) vaout[(size_t)s * AW + cc] = v; } }
    __syncthreads();
    const int t = c.tid >> 2, cq = c.tid & 3;
    if (t < n) { const int s_end = (t < 64) ? 64 : n;
        f32x4 acc[8];
#pragma unroll
        for (int e = 0; e < 8; ++e) acc[e] = (f32x4){0.f, 0.f, 0.f, 0.f};
        for (int s = 0; s < s_end; s += 4) { const f32x4 w4 = *(const LAS f32x4*)(Wl + t * 132 + s);
#pragma unroll
            for (int q = 0; q < 4; ++q) { const float w = w4[q]; const LAS f32x4* vr = (const LAS f32x4*)(vn + (s + q) * 128 + cq * 32);
#pragma unroll
                for (int e = 0; e < 8; ++e) acc[e] += vr[e] * w; } }
        const float bias = bs[t]; const size_t row = (size_t)(row0 + t);
        const v4u* up = (const v4u*)(U + row * AW + h * 128 + cq * 32); v4u* op = (v4u*)(AO + row * D + h * 128 + cq * 32);
#pragma unroll
        for (int e2 = 0; e2 < 4; ++e2) { float uf[8]; unpack8(up[e2], uf); const f32x4 a0 = acc[2 * e2] + bias, a1 = acc[2 * e2 + 1] + bias;
            v4u w; w.x = cvt_pk_bf16(uf[0] * a0.x, uf[1] * a0.y); w.y = cvt_pk_bf16(uf[2] * a0.z, uf[3] * a0.w); w.z = cvt_pk_bf16(uf[4] * a1.x, uf[5] * a1.y); w.w = cvt_pk_bf16(uf[6] * a1.z, uf[7] * a1.w); op[e2] = w; } }
    __syncthreads();
}

typedef float f32x16 __attribute__((ext_vector_type(16)));
typedef short s16x8 __attribute__((ext_vector_type(8)));
typedef short s16x4 __attribute__((ext_vector_type(4)));
__device__ __forceinline__ unsigned cvtpk(float lo, float hi) { typedef float f2_t __attribute__((ext_vector_type(2))); typedef __bf16 b2_t __attribute__((ext_vector_type(2))); f2_t v = {lo, hi}; b2_t b = __builtin_convertvector(v, b2_t); return __builtin_bit_cast(unsigned, b); }
__device__ __forceinline__ s16x8 pack8(float x0, float x1, float x2, float x3, float x4, float x5, float x6, float x7) { v4u w; w.x = cvtpk(x0, x1); w.y = cvtpk(x2, x3); w.z = cvtpk(x4, x5); w.w = cvtpk(x6, x7); return __builtin_bit_cast(s16x8, w); }
__device__ __forceinline__ s16x4 tr_read(const LAS unsigned char* p) { typedef short v4i16_t __attribute__((ext_vector_type(4))); return __builtin_bit_cast(s16x4, __builtin_amdgcn_ds_read_tr16_b64_v4i16((LAS v4i16_t*)p)); }
constexpr int AT_KP = 144, AT_VP = 192, AT_WAVE_LDS = 32 * AT_KP + 32 * AT_VP;
__device__ __forceinline__ void attn_wave_task(const Args& a, int j, int task, const Ctx& c) {
    LAS unsigned char* kl = c.lds + c.wave * AT_WAVE_LDS; LAS unsigned char* vl = kl + 32 * AT_KP;
    const float* QF = (const float*)(wsp(a) + WS_QF); bf16* AO = (bf16*)(wsp(a) + WS_AO);
    int h, row0, pos0, b = 0; const bool smp = task >= 2048;
    if (!smp) { h = task & 15; const int qb = task >> 4; row0 = qb * 64; pos0 = row0; } else { const int s = task - 2048; h = s & 15; b = s >> 4; row0 = MP + b * 64; pos0 = 2048; }
    const int lane = c.lane, r32 = lane & 31, hi = lane >> 5;
    s16x8 qf[2][4];
#pragma unroll
    for (int qt = 0; qt < 2; ++qt)
#pragma unroll
        for (int s = 0; s < 4; ++s) { const float* qp = QF + (size_t)(row0 + qt * 32 + r32) * 1024 + h * 64 + 16 * s + 8 * hi; const f32x4 x0 = *(const f32x4*)qp * 0.125f, x1 = *(const f32x4*)(qp + 4) * 0.125f;
            qf[qt][s] = pack8(x0.x, x0.y, x0.z, x0.w, x1.x, x1.y, x1.z, x1.w); }
    f32x16 o[2][2];
#pragma unroll
    for (int qt = 0; qt < 2; ++qt)
#pragma unroll
        for (int dt = 0; dt < 2; ++dt)
#pragma unroll
            for (int r = 0; r < 16; ++r) o[qt][dt][r] = 0.f;
    float R0 = 0.f, R1 = 0.f;
    const float* kp_new = smp ? outp(a) + OFF_KS + (size_t)j * MS * 1024 + (size_t)(b * 64) * 1024 + h * 64 : outp(a) + OFF_KP + (size_t)j * MP * 1024 + h * 64;
    const float* vp_new = smp ? outp(a) + OFF_VS + (size_t)j * MS * 1024 + (size_t)(b * 64) * 1024 + h * 64 : outp(a) + OFF_VP + (size_t)j * MP * 1024 + h * 64;
    const float* kp_old = inp(a, I_CK) + ((size_t)j * 16 + b) * 2048 * 1024 + h * 64; const float* vp_old = inp(a, I_CV) + ((size_t)j * 16 + b) * 2048 * 1024 + h * 64;
    const LAS unsigned char* vtr = vl + (4 * hi + ((lane & 15) >> 2)) * AT_VP + (16 * ((lane >> 4) & 1) + 4 * (lane & 3)) * 2;
    const LAS unsigned char* kfr = kl + r32 * AT_KP + 16 * hi;
    for (int jt = (pos0 + 64) / 32 - 1; jt >= 0; --jt) {
        const int kpos0 = jt * 32;
        const float* ksrc; const float* vsrc;
        if (smp && kpos0 < 2048) { ksrc = kp_old + (size_t)kpos0 * 1024; vsrc = vp_old + (size_t)kpos0 * 1024; }
        else { const int r = kpos0 - (smp ? 2048 : 0); ksrc = kp_new + (size_t)r * 1024; vsrc = vp_new + (size_t)r * 1024; }
#pragma unroll
        for (int k = 0; k < 8; ++k) { const int e = lane + 64 * k, key = e >> 4, d4 = e & 15;
            *(LAS v2u*)(kl + key * AT_KP + d4 * 8) = pk4(*(const f32x4*)(ksrc + (size_t)key * 1024 + d4 * 4));
            *(LAS v2u*)(vl + key * AT_VP + d4 * 8) = pk4(*(const f32x4*)(vsrc + (size_t)key * 1024 + d4 * 4)); }
        LDS_WAIT(); asm volatile("" ::: "memory");
        f32x16 st0, st1;
#pragma unroll
        for (int r = 0; r < 16; ++r) { st0[r] = 0.f; st1[r] = 0.f; }
#pragma unroll
        for (int s = 0; s < 4; ++s) { const s16x8 kf = *(const LAS s16x8*)(kfr + 32 * s);
            st0 = __builtin_amdgcn_mfma_f32_32x32x16_bf16(kf, qf[0][s], st0, 0, 0, 0); st1 = __builtin_amdgcn_mfma_f32_32x32x16_bf16(kf, qf[1][s], st1, 0, 0, 0); }
#pragma unroll
        for (int qt = 0; qt < 2; ++qt) {
            const int ipos = pos0 + qt * 32 + r32; const float Rc = qt ? R1 : R0;
            float lf[16], ls[16];
#pragma unroll
            for (int r = 0; r < 16; ++r) { const float z = qt ? st1[r] : st0[r]; const bool valid = (kpos0 + (r & 3) + 8 * (r >> 2) + 4 * hi) < ipos;
                const float sp = fmaxf(z, 0.f) + __logf(1.f + __expf(-fabsf(z)));
                lf[r] = valid ? -sp : 0.f; ls[r] = valid ? z - sp : -1e30f; }
            float Gs[4], GP[4];
#pragma unroll
            for (int g = 0; g < 4; ++g) { Gs[g] = (lf[4 * g] + lf[4 * g + 1]) + (lf[4 * g + 2] + lf[4 * g + 3]);
                const auto rr = __builtin_amdgcn_permlane32_swap(__float_as_uint(Gs[g]), __float_as_uint(Gs[g]), false, false); GP[g] = __uint_as_float(hi ? rr[0] : rr[1]); }
            const float T2 = Gs[3], T1 = T2 + Gs[2], T0 = T1 + Gs[1];
            const float P3 = GP[3], P2 = P3 + GP[2], P1 = P2 + GP[1], P0 = P1 + GP[0];
            float later[4]; later[3] = hi ? 0.f : P3; later[2] = T2 + (hi ? P3 : P2); later[1] = T1 + (hi ? P2 : P1); later[0] = T0 + (hi ? P1 : P0);
            float w[16];
#pragma unroll
            for (int g = 0; g < 4; ++g) { const float A3 = Rc + later[g], A2 = A3 + lf[4 * g + 3], A1 = A2 + lf[4 * g + 2], A0 = A1 + lf[4 * g + 1];
                w[4 * g + 3] = __expf(ls[4 * g + 3] + A3); w[4 * g + 2] = __expf(ls[4 * g + 2] + A2); w[4 * g + 1] = __expf(ls[4 * g + 1] + A1); w[4 * g] = __expf(ls[4 * g] + A0); }
            const float Rn = Rc + ((T0 + Gs[0]) + P0);
            if (qt) R1 = Rn; else R0 = Rn;
            const s16x8 pf0 = pack8(w[0], w[1], w[2], w[3], w[4], w[5], w[6], w[7]), pf1 = pack8(w[8], w[9], w[10], w[11], w[12], w[13], w[14], w[15]);
#pragma unroll
            for (int dt = 0; dt < 2; ++dt) {
                const s16x4 v00 = tr_read(vtr + dt * 64), v01 = tr_read(vtr + dt * 64 + 8 * AT_VP), v10 = tr_read(vtr + dt * 64 + 16 * AT_VP), v11 = tr_read(vtr + dt * 64 + 24 * AT_VP);
                const s16x8 vf0 = (s16x8){v00[0], v00[1], v00[2], v00[3], v01[0], v01[1], v01[2], v01[3]}, vf1 = (s16x8){v10[0], v10[1], v10[2], v10[3], v11[0], v11[1], v11[2], v11[3]};
                o[qt][dt] = __builtin_amdgcn_mfma_f32_32x32x16_bf16(pf0, vf0, o[qt][dt], 0, 0, 0);
                o[qt][dt] = __builtin_amdgcn_mfma_f32_32x32x16_bf16(pf1, vf1, o[qt][dt], 0, 0, 0); }
        }
        LDS_WAIT(); asm volatile("" ::: "memory");
        if (__all(R0 < -SB_THRESH && R1 < -SB_THRESH)) break;
    }
#pragma unroll
    for (int qt = 0; qt < 2; ++qt)
#pragma unroll
        for (int dt = 0; dt < 2; ++dt)
#pragma unroll
            for (int r = 0; r < 16; ++r) { const int q = qt * 32 + (r & 3) + 8 * (r >> 2) + 4 * hi;
                AO[(size_t)(row0 + q) * D + 1024 + h * 64 + dt * 32 + r32] = (bf16)(cvtpk(o[qt][dt][r], 0.f) & 0xffffu); }
}
__device__ __forceinline__ void even_mix_phase(const Args& a, int j, const Ctx& c) {
    for (int task = blockIdx.x; task < 928; task += gridDim.x) {
        if (task < 512) spatial_task(a, j, (task >> 3) * 128, 128, task & 7, c);
        else if (task < 640) spatial_task(a, j, MP + ((task - 512) >> 3) * 64, 64, task & 7, c);
        else attn_wave_task(a, j, (task - 640) * 8 + c.wave, c);
    }
}

constexpr int CK_P = 144, CK_IMG = 64 * CK_P;
enum { IM_AT = 0, IM_RT, IM_BH, IM_KH, IM_VM, IM_BT, IM_KT, IM_AAK, IM_ARB, IM_ARK, IM_XA, IM_XB, IM_TA, IM_TB, IM_COUNT };
constexpr int CK_SCR = IM_COUNT * CK_IMG, CK_WLE = CK_SCR + 16384;
static_assert(CK_WLE + 256 <= LDSCTL_OFF, "chunk phase LDS map");
constexpr int N_CHUNKS = 4096 + 512;
__device__ __forceinline__ s16x8 op_row(const LAS unsigned char* img, int row, int ks, int kq) { return *(const LAS s16x8*)(img + row * CK_P + (32 * ks + 8 * kq) * 2); }
__device__ __forceinline__ s16x8 op_tr(const LAS unsigned char* img, int col0, int ks, int kq, int i16) {
    const LAS unsigned char* p = img + (32 * ks + 8 * kq + (i16 >> 2)) * CK_P + (col0 + 4 * (i16 & 3)) * 2; const s16x4 lo = tr_read(p), hi = tr_read(p + 4 * CK_P);
    return (s16x8){lo[0], lo[1], lo[2], lo[3], hi[0], hi[1], hi[2], hi[3]}; }
template <bool ATR, bool BTR> __device__ __forceinline__ void mm2(const LAS unsigned char* Ai, const LAS unsigned char* Bi, int mt0, int nt, int i16, int kq, f32x4& c0, f32x4& c1) {
#pragma unroll
    for (int ks = 0; ks < 2; ++ks) {
        const s16x8 b = BTR ? op_tr(Bi, 16 * nt, ks, kq, i16) : op_row(Bi, 16 * nt + i16, ks, kq);
        const s16x8 a0 = ATR ? op_tr(Ai, 16 * mt0, ks, kq, i16) : op_row(Ai, 16 * mt0 + i16, ks, kq);
        const s16x8 a1 = ATR ? op_tr(Ai, 16 * mt0 + 16, ks, kq, i16) : op_row(Ai, 16 * mt0 + 16 + i16, ks, kq);
        c0 = __builtin_amdgcn_mfma_f32_16x16x32_bf16(a0, b, c0, 0, 0, 0); c1 = __builtin_amdgcn_mfma_f32_16x16x32_bf16(a1, b, c1, 0, 0, 0); }
}
__device__ __forceinline__ void st_timg(LAS unsigned char* img, int mt, int nt, int i16, int q, f32x4 v) { *(LAS v2u*)(img + (16 * nt + i16) * CK_P + (16 * mt + 4 * q) * 2) = pk4(v); }
__device__ __forceinline__ f32x4 ld_timg(const LAS unsigned char* img, int mt, int nt, int i16, int q) { const v2u w = *(const LAS v2u*)(img + (16 * nt + i16) * CK_P + (16 * mt + 4 * q) * 2); return (f32x4){bf_lo(w.x), bf_hi(w.x), bf_lo(w.y), bf_hi(w.y)}; }

struct ChunkRaw { f32x4 r[2], k[2], v[2], lw[2], vf[2], kkp[2], kap[2]; v4u aa, vg; };
__device__ __forceinline__ void chunk_load(const Args& a, int j, bool first, int row0, int h, int tid, ChunkRaw& R) {
    const int t = tid >> 3, c0 = (tid & 7) * 8; const size_t off = (size_t)(row0 + t) * D + h * 64 + c0; const int ch = h * 64 + c0;
    const f32x4* pr = (const f32x4*)((const float*)(wsp(a) + WS_R) + off); const f32x4* pk = (const f32x4*)((const float*)(wsp(a) + WS_K) + off); const f32x4* pv = (const f32x4*)((const float*)(wsp(a) + (first ? WS_V1 : WS_V3)) + off);
    const f32x4* pw = (const f32x4*)((const float*)(wsp(a) + WS_WD) + off); const f32x4* pkk = (const f32x4*)(inp(a, I_KK) + (size_t)j * D + ch); const f32x4* pka = (const f32x4*)(inp(a, I_KA) + (size_t)j * D + ch);
    R.r[0] = pr[0]; R.r[1] = pr[1]; R.k[0] = pk[0]; R.k[1] = pk[1]; R.v[0] = pv[0]; R.v[1] = pv[1]; R.lw[0] = pw[0]; R.lw[1] = pw[1]; R.kkp[0] = pkk[0]; R.kkp[1] = pkk[1]; R.kap[0] = pka[0]; R.kap[1] = pka[1];
    R.aa = *(const v4u*)((const bf16*)(wsp(a) + WS_AA) + off);
    if (!first) { const f32x4* pf = (const f32x4*)((const float*)(wsp(a) + WS_V1) + off); R.vf[0] = pf[0]; R.vf[1] = pf[1]; R.vg = *(const v4u*)((const bf16*)(wsp(a) + WS_VG) + off); }
}
__device__ __forceinline__ void f8(const f32x4 (&x)[2], float (&f)[8]) { f[0] = x[0].x; f[1] = x[0].y; f[2] = x[0].z; f[3] = x[0].w; f[4] = x[1].x; f[5] = x[1].y; f[6] = x[1].z; f[7] = x[1].w; }
__device__ __forceinline__ void chunk_prep(const ChunkRaw& R, bool first, const Ctx& c) {
    LAS unsigned char* L = c.lds;
#define IMG(k) (L + (k) * CK_IMG)
    LAS float* scr = (LAS float*)(L + CK_SCR); LAS float* segt = (LAS float*)IMG(IM_XB); LAS float* wle = (LAS float*)(L + CK_WLE);
    const int tid = c.tid, t = tid >> 3, sub = tid & 7, c0 = sub * 8;
    float r[8], kp[8], v[8], lw[8], av[8], bv[8];
    { float k[8], aa[8], kkp[8], kap[8]; f8(R.r, r); f8(R.k, k); f8(R.v, v); f8(R.lw, lw); f8(R.kkp, kkp); f8(R.kap, kap); unpack8(R.aa, aa);
      if (!first) { float vf[8], vg[8]; f8(R.vf, vf); unpack8(R.vg, vg);
#pragma unroll
          for (int e = 0; e < 8; ++e) v[e] = v[e] + (vf[e] - v[e]) * vg[e]; }
      float kk[8], ss = 0.f;
#pragma unroll
      for (int e = 0; e < 8; ++e) { kk[e] = k[e] * kkp[e]; ss += kk[e] * kk[e]; }
      ss = reduce8(ss); const float inv = 1.f / fmaxf(sqrtf(ss), 1e-12f);
#pragma unroll
      for (int e = 0; e < 8; ++e) { const float kn = kk[e] * inv; av[e] = -kn; bv[e] = kn * aa[e]; kp[e] = k[e] * (1.f + (aa[e] - 1.f) * kap[e]); } }
    *(LAS f32x4*)(scr + t * 64 + c0) = (f32x4){lw[0], lw[1], lw[2], lw[3]}; *(LAS f32x4*)(scr + t * 64 + c0 + 4) = (f32x4){lw[4], lw[5], lw[6], lw[7]};
    __syncthreads();
    { const int jj = tid & 63, seg = tid >> 6; float run = 0.f;
#pragma unroll
      for (int u = 0; u < 8; ++u) { run += scr[(8 * seg + u) * 64 + jj]; scr[(8 * seg + u) * 64 + jj] = run; }
      segt[seg * 64 + jj] = run; }
    __syncthreads();
    { float cum[8], tot[8];
      { const f32x4 x0 = *(const LAS f32x4*)(scr + t * 64 + c0), x1 = *(const LAS f32x4*)(scr + t * 64 + c0 + 4); cum[0] = x0.x; cum[1] = x0.y; cum[2] = x0.z; cum[3] = x0.w; cum[4] = x1.x; cum[5] = x1.y; cum[6] = x1.z; cum[7] = x1.w; }
#pragma unroll
      for (int e = 0; e < 8; ++e) tot[e] = 0.f;
#pragma unroll
      for (int sg = 0; sg < 8; ++sg) { const f32x4 x0 = *(const LAS f32x4*)(segt + sg * 64 + c0), x1 = *(const LAS f32x4*)(segt + sg * 64 + c0 + 4); const float xs[8] = {x0.x, x0.y, x0.z, x0.w, x1.x, x1.y, x1.z, x1.w};
#pragma unroll
          for (int e = 0; e < 8; ++e) { tot[e] += xs[e]; if (sg < (t >> 3)) cum[e] += xs[e]; } }
      float oA[8], oB[8], oK[8], oR[8], oBh[8], oKh[8];
#pragma unroll
      for (int e = 0; e < 8; ++e) { const float en = __expf(-cum[e]), eh = __expf(tot[e] - cum[e]);
          oA[e] = av[e] * __expf(cum[e] - lw[e]); oB[e] = bv[e] * en; oK[e] = kp[e] * en; oR[e] = r[e] * __expf(cum[e]); oBh[e] = bv[e] * eh; oKh[e] = kp[e] * eh; }
      const int io = t * CK_P + c0 * 2;
#define ST8(k, ARR) do { *(LAS s16x8*)(IMG(k) + io) = pack8(ARR[0], ARR[1], ARR[2], ARR[3], ARR[4], ARR[5], ARR[6], ARR[7]); } while (0)
      ST8(IM_AT, oA); ST8(IM_BT, oB); ST8(IM_KT, oK); ST8(IM_RT, oR); ST8(IM_BH, oBh); ST8(IM_KH, oKh); ST8(IM_VM, v);
#undef ST8
      if (t == 0) {
#pragma unroll
          for (int e = 0; e < 8; ++e) wle[c0 + e] = __expf(tot[e]); } }
    __syncthreads();
#undef IMG
}
__device__ __forceinline__ void chunk_mats(const Args& a, int cid, int row0, int h, const Ctx& c) {
    LAS unsigned char* L = c.lds;
#define IMG(k) (L + (k) * CK_IMG)
    LAS float* wle = (LAS float*)(L + CK_WLE);
    const int w = c.wave, lane = c.lane, i16 = lane & 15, q = lane >> 4, mt0 = 2 * (w & 1), nt = w >> 1;
    const f32x4 z4 = (f32x4){0.f, 0.f, 0.f, 0.f};
    f32x4 T0, T1;
    { f32x4 ab0 = z4, ab1 = z4, ak0 = z4, ak1 = z4, rb0 = z4, rb1 = z4, rk0 = z4, rk1 = z4;
      mm2<false, false>(IMG(IM_BT), IMG(IM_AT), mt0, nt, i16, q, ab0, ab1); mm2<false, false>(IMG(IM_KT), IMG(IM_AT), mt0, nt, i16, q, ak0, ak1);
      mm2<false, false>(IMG(IM_BT), IMG(IM_RT), mt0, nt, i16, q, rb0, rb1); mm2<false, false>(IMG(IM_KT), IMG(IM_RT), mt0, nt, i16, q, rk0, rk1);
      const int tc = 16 * nt + i16;
#pragma unroll
      for (int rr = 0; rr < 4; ++rr) { const int s0 = 16 * mt0 + 4 * q + rr, s1 = s0 + 16;
          ab0[rr] = s0 < tc ? ab0[rr] : 0.f; ab1[rr] = s1 < tc ? ab1[rr] : 0.f; ak0[rr] = s0 < tc ? ak0[rr] : 0.f; ak1[rr] = s1 < tc ? ak1[rr] : 0.f;
          rb0[rr] = s0 <= tc ? rb0[rr] : 0.f; rb1[rr] = s1 <= tc ? rb1[rr] : 0.f; rk0[rr] = s0 <= tc ? rk0[rr] : 0.f; rk1[rr] = s1 <= tc ? rk1[rr] : 0.f;
          T0[rr] = ab0[rr] + (s0 == tc ? 1.f : 0.f); T1[rr] = ab1[rr] + (s1 == tc ? 1.f : 0.f); }
      st_timg(IMG(IM_XA), mt0, nt, i16, q, ab0); st_timg(IMG(IM_XA), mt0 + 1, nt, i16, q, ab1); st_timg(IMG(IM_AAK), mt0, nt, i16, q, ak0); st_timg(IMG(IM_AAK), mt0 + 1, nt, i16, q, ak1);
      st_timg(IMG(IM_ARB), mt0, nt, i16, q, rb0); st_timg(IMG(IM_ARB), mt0 + 1, nt, i16, q, rb1); st_timg(IMG(IM_ARK), mt0, nt, i16, q, rk0); st_timg(IMG(IM_ARK), mt0 + 1, nt, i16, q, rk1);
      st_timg(IMG(IM_TA), mt0, nt, i16, q, T0); st_timg(IMG(IM_TA), mt0 + 1, nt, i16, q, T1); }
    __syncthreads();
#pragma unroll
    for (int st = 1; st <= 6; ++st) {
        LAS unsigned char* Xs = IMG((st & 1) ? IM_XA : IM_XB); LAS unsigned char* Xd = IMG((st & 1) ? IM_XB : IM_XA); LAS unsigned char* Ts = IMG((st & 1) ? IM_TB : IM_TA); LAS unsigned char* Td = IMG((st & 1) ? IM_TA : IM_TB);
        if (st <= 5) { f32x4 x0 = z4, x1 = z4; mm2<true, false>(Xs, Xs, mt0, nt, i16, q, x0, x1); st_timg(Xd, mt0, nt, i16, q, x0); st_timg(Xd, mt0 + 1, nt, i16, q, x1); }
        if (st >= 2) { mm2<true, false>(Ts, Xs, mt0, nt, i16, q, T0, T1); st_timg(Td, mt0, nt, i16, q, T0); st_timg(Td, mt0 + 1, nt, i16, q, T1); }
        __syncthreads();
    }
    { f32x4 h0 = z4, h1 = z4, g0 = z4, g1 = z4;
      mm2<true, false>(IMG(IM_AT), IMG(IM_TB), mt0, nt, i16, q, h0, h1); mm2<true, false>(IMG(IM_AAK), IMG(IM_TB), mt0, nt, i16, q, g0, g1);
      st_timg(IMG(IM_BT), mt0, nt, i16, q, h0); st_timg(IMG(IM_BT), mt0 + 1, nt, i16, q, h1); st_timg(IMG(IM_KT), mt0, nt, i16, q, g0); st_timg(IMG(IM_KT), mt0 + 1, nt, i16, q, g1); }
    __syncthreads();
    unsigned char* crp = wsp(a) + WS_CRP + (size_t)cid * 16384; unsigned char* cq = wsp(a) + WS_CQ + (size_t)cid * 16384;
    { f32x4 p0 = ld_timg(IMG(IM_RT), mt0, nt, i16, q), p1 = ld_timg(IMG(IM_RT), mt0 + 1, nt, i16, q), h0 = ld_timg(IMG(IM_ARK), mt0, nt, i16, q), h1 = ld_timg(IMG(IM_ARK), mt0 + 1, nt, i16, q);
      mm2<true, false>(IMG(IM_BT), IMG(IM_ARB), mt0, nt, i16, q, p0, p1); mm2<true, false>(IMG(IM_KT), IMG(IM_ARB), mt0, nt, i16, q, h0, h1);
      *(s16x8*)(crp + ((nt * 2 + (w & 1)) * 64 + lane) * 16) = pack8(p0.x, p0.y, p0.z, p0.w, p1.x, p1.y, p1.z, p1.w);
      st_timg(IMG(IM_XA), mt0, nt, i16, q, h0); st_timg(IMG(IM_XA), mt0 + 1, nt, i16, q, h1); }
    { f32x4 p0 = z4, p1 = z4, m0, m1; const int jc = 16 * nt + i16;
#pragma unroll
      for (int rr = 0; rr < 4; ++rr) { const int s0 = 16 * mt0 + 4 * q + rr, s1 = s0 + 16; if (s0 == jc) p0[rr] = wle[jc]; if (s1 == jc) p1[rr] = wle[jc];
          m0[rr] = __uint_as_float((unsigned)*(const LAS unsigned short*)(IMG(IM_KH) + s0 * CK_P + jc * 2) << 16); m1[rr] = __uint_as_float((unsigned)*(const LAS unsigned short*)(IMG(IM_KH) + s1 * CK_P + jc * 2) << 16); }
      mm2<true, true>(IMG(IM_BT), IMG(IM_BH), mt0, nt, i16, q, p0, p1); mm2<true, true>(IMG(IM_KT), IMG(IM_BH), mt0, nt, i16, q, m0, m1);
      *(s16x8*)(crp + 8192 + ((nt * 2 + (w & 1)) * 64 + lane) * 16) = pack8(p0.x, p0.y, p0.z, p0.w, p1.x, p1.y, p1.z, p1.w);
      st_timg(IMG(IM_XB), mt0, nt, i16, q, m0); st_timg(IMG(IM_XB), mt0 + 1, nt, i16, q, m1); }
    __syncthreads();
    { f32x4 q0 = z4, q1 = z4, y0 = z4, y1 = z4;
      mm2<false, true>(IMG(IM_XB), IMG(IM_VM), mt0, nt, i16, q, q0, q1); mm2<false, true>(IMG(IM_XA), IMG(IM_VM), mt0, nt, i16, q, y0, y1);
      *(f32x4*)(cq + ((nt * 4 + mt0) * 64 + lane) * 16) = q0; *(f32x4*)(cq + ((nt * 4 + mt0 + 1) * 64 + lane) * 16) = q1;
      float* ys = (float*)(wsp(a) + WS_YS) + (size_t)row0 * D + h * 64 + 16 * nt + i16;
#pragma unroll
      for (int rr = 0; rr < 4; ++rr) { ys[(size_t)(16 * mt0 + 4 * q + rr) * D] = y0[rr]; ys[(size_t)(16 * mt0 + 16 + 4 * q + rr) * D] = y1[rr]; } }
    __syncthreads();
#undef IMG
}
__device__ __forceinline__ void chunk_decode(int task, int& h, int& row0) { if (task < 4096) { h = task & 31; row0 = (task >> 5) * 64; } else { const int s = task - 4096; h = s & 31; row0 = MP + (s >> 5) * 64; } }
__device__ __forceinline__ void chunk_phase(const Args& a, int j, const Ctx& c) {
    const bool first = (j == 0); ChunkRaw R; int h, row0;
    int task = blockIdx.x; if (task < N_CHUNKS) { chunk_decode(task, h, row0); chunk_load(a, j, first, row0, h, c.tid, R); }
    for (; task < N_CHUNKS; task += gridDim.x) {
        chunk_prep(R, first, c);
        const int ch = h, cr = row0, nxt = task + gridDim.x;
        if (nxt < N_CHUNKS) { chunk_decode(nxt, h, row0); chunk_load(a, j, first, row0, h, c.tid, R); }
        chunk_mats(a, task, cr, ch, c);
    }
}
constexpr int CH_SLOT = 24576, CH_NSLOT = 5, CH_D = 4;
__device__ __forceinline__ void chain_pack(const f32x4 (&S)[4], s16x8 (&hi)[2], s16x8 (&lo)[2]) {
#pragma unroll
    for (int ks = 0; ks < 2; ++ks) { const f32x4 u0 = S[2 * ks], u1 = S[2 * ks + 1]; v4u wv; wv.x = cvt_pk_bf16(u0.x, u0.y); wv.y = cvt_pk_bf16(u0.z, u0.w); wv.z = cvt_pk_bf16(u1.x, u1.y); wv.w = cvt_pk_bf16(u1.z, u1.w);
        hi[ks] = __builtin_bit_cast(s16x8, wv);
        lo[ks] = pack8(u0.x - bf_lo(wv.x), u0.y - bf_hi(wv.x), u0.z - bf_lo(wv.y), u0.w - bf_hi(wv.y), u1.x - bf_lo(wv.z), u1.y - bf_hi(wv.z), u1.z - bf_lo(wv.w), u1.w - bf_hi(wv.w)); }
}
__device__ __forceinline__ void chain_store_state(unsigned char* sc, int cid, int rg, int lane, const s16x8 (&hi)[2], const s16x8 (&lo)[2]) {
    unsigned char* p = sc + ((size_t)(cid * 4 + rg) * 4) * 1024 + lane * 16; *(s16x8*)p = hi[0]; *(s16x8*)(p + 1024) = hi[1]; *(s16x8*)(p + 2048) = lo[0]; *(s16x8*)(p + 3072) = lo[1];
}
__device__ __forceinline__ void chain_phase(const Args& a, int j, const Ctx& c) {
    const int G = gridDim.x, bid = blockIdx.x, lane = c.lane, i16 = lane & 15, q = lane >> 4;
    unsigned char* sc = wsp(a) + WS_SC; const unsigned char* crp = wsp(a) + WS_CRP; const unsigned char* cqb = wsp(a) + WS_CQ;
    if (bid < 32 && G > 32) {
        const int h = bid; LAS unsigned char* ring = c.lds;
        if (c.wave >= 4) {
            const int lw = c.wave - 4;
#define CH_ISSUE(cc_) do { const size_t cid_ = (size_t)(cc_) * 32 + h; LAS unsigned char* sl_ = ring + ((cc_) % CH_NSLOT) * CH_SLOT; \
            _Pragma("unroll") for (int e_ = 0; e_ < 6; ++e_) { const int pc_ = lw * 6 + e_; const unsigned char* g_ = (pc_ < 8 ? crp + cid_ * 16384 + 8192 + pc_ * 1024 : cqb + cid_ * 16384 + (pc_ - 8) * 1024) + lane * 16; \
                __builtin_amdgcn_global_load_lds((const unsigned*)g_, (LAS unsigned*)(sl_ + pc_ * 1024), 16, 0, 0); } } while (0)
#pragma unroll
            for (int cc = 0; cc < CH_D; ++cc) CH_ISSUE(cc);
            asm volatile("s_waitcnt vmcnt(18)" ::: "memory");
            __builtin_amdgcn_s_barrier();
            for (int cc = 0; cc < 128; ++cc) {
                if (cc + CH_D < 128) { CH_ISSUE(cc + CH_D); asm volatile("s_waitcnt vmcnt(18)" ::: "memory"); } else asm volatile("s_waitcnt vmcnt(0)" ::: "memory");
                __builtin_amdgcn_s_barrier();
            }
#undef CH_ISSUE
        } else {
            const int rg = c.wave; f32x4 S[4];
#pragma unroll
            for (int m = 0; m < 4; ++m) S[m] = (f32x4){0.f, 0.f, 0.f, 0.f};
            __builtin_amdgcn_s_barrier();
            for (int cc = 0; cc < 128; ++cc) {
                const LAS unsigned char* sl = ring + (cc % CH_NSLOT) * CH_SLOT;
                s16x8 hi[2], lo[2]; chain_pack(S, hi, lo); chain_store_state(sc, cc * 32 + h, rg, lane, hi, lo);
#pragma unroll
                for (int m = 0; m < 4; ++m) { f32x4 n = *(const LAS f32x4*)(sl + 8192 + ((rg * 4 + m) * 64 + lane) * 16);
#pragma unroll
                    for (int ks = 0; ks < 2; ++ks) { const s16x8 pf = *(const LAS s16x8*)(sl + ((m * 2 + ks) * 64 + lane) * 16);
                        n = __builtin_amdgcn_mfma_f32_16x16x32_bf16(pf, hi[ks], n, 0, 0, 0); n = __builtin_amdgcn_mfma_f32_16x16x32_bf16(pf, lo[ks], n, 0, 0, 0); }
                    S[m] = n; }
                asm volatile("s_waitcnt lgkmcnt(0)" ::: "memory");
                __builtin_amdgcn_s_barrier();
            }
            float* sout = outp(a) + OFF_WKVP + ((size_t)j * 32 + h) * 4096; const int i = rg * 16 + i16;
#pragma unroll
            for (int m = 0; m < 4; ++m) *(f32x4*)(sout + (size_t)i * 64 + 16 * m + 4 * q) = S[m];
        }
    } else {
        const int nb = (G > 32) ? G - 32 : G, rank = ((G > 32) ? bid - 32 : bid) * 8 + c.wave;
        for (int s = rank; s < 2048; s += nb * 8) { const int b = s >> 7, h = (s >> 2) & 31, rg = s & 3, cid = 4096 + b * 32 + h, i = rg * 16 + i16; const size_t so = (((size_t)j * 16 + b) * 32 + h) * 4096;
            const float* s0 = inp(a, I_WKV) + so; float* sout = outp(a) + OFF_WKVS + so; f32x4 S[4];
#pragma unroll
            for (int m = 0; m < 4; ++m) S[m] = *(const f32x4*)(s0 + (size_t)i * 64 + 16 * m + 4 * q);
            s16x8 hi[2], lo[2]; chain_pack(S, hi, lo); chain_store_state(sc, cid, rg, lane, hi, lo);
#pragma unroll
            for (int m = 0; m < 4; ++m) { f32x4 n = *(const f32x4*)(cqb + (size_t)cid * 16384 + ((rg * 4 + m) * 64 + lane) * 16);
#pragma unroll
                for (int ks = 0; ks < 2; ++ks) { const s16x8 pf = *(const s16x8*)(crp + (size_t)cid * 16384 + 8192 + ((m * 2 + ks) * 64 + lane) * 16);
                    n = __builtin_amdgcn_mfma_f32_16x16x32_bf16(pf, hi[ks], n, 0, 0, 0); n = __builtin_amdgcn_mfma_f32_16x16x32_bf16(pf, lo[ks], n, 0, 0, 0); }
                *(f32x4*)(sout + (size_t)i * 64 + 16 * m + 4 * q) = n; }
        }
    }
}
__device__ __forceinline__ void ychunk_phase(const Args& a, const Ctx& c) {
    const int lane = c.lane, i16 = lane & 15, q = lane >> 4;
    const unsigned char* sc = wsp(a) + WS_SC; const unsigned char* crp = wsp(a) + WS_CRP; float* YS = (float*)(wsp(a) + WS_YS);
    for (int wt = c.gw; wt < N_CHUNKS * 4; wt += c.NGW) { const int cid = wt >> 2, rg = wt & 3; int h, row0; if (cid < 4096) { h = cid & 31; row0 = (cid >> 5) * 64; } else { const int s = cid - 4096; h = s & 31; row0 = MP + (s >> 5) * 64; }
        const unsigned char* sp = sc + ((size_t)(cid * 4 + rg) * 4) * 1024 + lane * 16; const s16x8 hi0 = *(const s16x8*)sp, hi1 = *(const s16x8*)(sp + 1024), lo0 = *(const s16x8*)(sp + 2048), lo1 = *(const s16x8*)(sp + 3072);
        float* ys = YS + (size_t)row0 * D + h * 64 + rg * 16 + i16;
#pragma unroll
        for (int m = 0; m < 4; ++m) { const s16x8 r0 = *(const s16x8*)(crp + (size_t)cid * 16384 + ((m * 2) * 64 + lane) * 16), r1 = *(const s16x8*)(crp + (size_t)cid * 16384 + ((m * 2 + 1) * 64 + lane) * 16);
            f32x4 y;
#pragma unroll
            for (int rr = 0; rr < 4; ++rr) y[rr] = ys[(size_t)(16 * m + 4 * q + rr) * D];
            y = __builtin_amdgcn_mfma_f32_16x16x32_bf16(r0, hi0, y, 0, 0, 0); y = __builtin_amdgcn_mfma_f32_16x16x32_bf16(r0, lo0, y, 0, 0, 0);
            y = __builtin_amdgcn_mfma_f32_16x16x32_bf16(r1, hi1, y, 0, 0, 0); y = __builtin_amdgcn_mfma_f32_16x16x32_bf16(r1, lo1, y, 0, 0, 0);
#pragma unroll
            for (int rr = 0; rr < 4; ++rr) ys[(size_t)(16 * m + 4 * q + rr) * D] = y[rr]; }
    }
}

__device__ __forceinline__ void post_phase(const Args& a, int j, const Ctx& c) {
    const bool first = (j == 0);
    const float* YS = (const float*)(wsp(a) + WS_YS); const float* R = (const float*)(wsp(a) + WS_R); const float* K = (const float*)(wsp(a) + WS_K); const float* V = (const float*)(wsp(a) + (first ? WS_V1 : WS_V3));
    const float* VF = (const float*)(wsp(a) + WS_V1); const bf16* AA = (const bf16*)(wsp(a) + WS_AA); const bf16* VG = (const bf16*)(wsp(a) + WS_VG); const bf16* GG = (const bf16*)(wsp(a) + WS_GG); bf16* YG = (bf16*)(wsp(a) + WS_YG);
    const float* kap = inp(a, I_KA) + (size_t)j * D; const float* rkp = inp(a, I_RK) + (size_t)j * D; const float* gng = inp(a, I_GNG) + (size_t)j * D; const float* gnb = inp(a, I_GNB) + (size_t)j * D;
    const int g = c.lane >> 4, l16 = c.lane & 15;
    for (int wi = c.gw; wi < M * 32 / 4; wi += c.NGW) { const int item = wi * 4 + g, row = item >> 5, h = item & 31, ch = h * 64 + l16 * 4; const size_t off = (size_t)row * D + ch;
        const f32x4 y = *(const f32x4*)(YS + off), r = *(const f32x4*)(R + off), k = *(const f32x4*)(K + off); f32x4 v = *(const f32x4*)(V + off);
        const v2u aw = *(const v2u*)(AA + off), gw2 = *(const v2u*)(GG + off);
        const f32x4 aa = (f32x4){bf_lo(aw.x), bf_hi(aw.x), bf_lo(aw.y), bf_hi(aw.y)}, gg = (f32x4){bf_lo(gw2.x), bf_hi(gw2.x), bf_lo(gw2.y), bf_hi(gw2.y)};
        if (!first) { const f32x4 vf = *(const f32x4*)(VF + off); const v2u vw = *(const v2u*)(VG + off); const f32x4 vg = (f32x4){bf_lo(vw.x), bf_hi(vw.x), bf_lo(vw.y), bf_hi(vw.y)}; v = v + (vf - v) * vg; }
        const f32x4 ka4 = *(const f32x4*)(kap + ch), rk4 = *(const f32x4*)(rkp + ch), g4 = *(const f32x4*)(gng + ch), b4 = *(const f32x4*)(gnb + ch);
        const f32x4 k2 = k * ((aa - 1.f) * ka4 + 1.f);
        const float mean = reduce16((y.x + y.y) + (y.z + y.w)) * (1.f / 64.f); const f32x4 dy = y - mean;
        const float var = reduce16((dy.x * dy.x + dy.y * dy.y) + (dy.z * dy.z + dy.w * dy.w)) * (1.f / 64.f);
        const float rstd = 1.f / sqrtf(var + GN_EPS);
        const f32x4 rk = r * k2 * rk4; const float bonus = reduce16((rk.x + rk.y) + (rk.z + rk.w));
        const f32x4 o = (dy * rstd * g4 + b4 + v * bonus) * gg;
        *(v2u*)(YG + off) = pk4(o); }
}

constexpr int PH_PER_LAYER = 14;
constexpr int N_PHASES = 1 + PH_PER_LAYER * 4;
__host__ __device__ constexpr bool phase_exists(int ph) { return ph == 0 || (ph < N_PHASES && !((((ph - 1) / PH_PER_LAYER) & 1) == 0 && ((ph - 1) % PH_PER_LAYER) >= 2 && ((ph - 1) % PH_PER_LAYER) <= 6)); }

__global__ void __launch_bounds__(NTHREADS, 2) fwd_kernel(Args args) {
    extern __shared__ __attribute__((aligned(16))) unsigned char lds_raw[];
    LAS unsigned char* lds = (LAS unsigned char*)lds_raw;
    const int G = gridDim.x;
    const int lo = args.ph_lo, hi = args.ph_hi; const bool fused = (hi - lo) > 1;
    if (threadIdx.x < 64) ((LAS unsigned*)(lds + LDSCTL_OFF))[threadIdx.x] = 0u;
    __syncthreads();
    XcdBarrier bar; bar.bar = (unsigned*)(wsp(args) + WS_CTL) + CW_BAR; bar.x = 0; bar.st = nullptr;
    if (fused) bar = xcd_barrier_post((unsigned*)(wsp(args) + WS_CTL) + CW_BAR, (volatile LAS unsigned*)(lds + LDSCTL_OFF));
#ifndef PHMASK
#define PHMASK 0xFFFFFFFFu
#endif
#define SEL(b) (((PHMASK) >> (b)) & 1u)
#define IN(k) (lo <= (k) && (k) < hi)
#define SEAM() do { if (fused) xcd_barrier(bar); } while (0)

#ifndef PROBE_MASK
#define PROBE_MASK 0u
#endif
#define PROBE(b) (((PROBE_MASK) >> (b)) & 1u)
#define SITE(bit, ph, ...) do { if (SEL(bit) && IN(ph)) { { __VA_ARGS__ } SEAM(); if (PROBE(bit)) { { __VA_ARGS__ } SEAM(); } } } while (0)

    SITE(0, 0, const Ctx c = make_ctx(lds); p0_prologue(args, c););

    for (int L = 0; L < 4; ++L) {
        const int base = 1 + PH_PER_LAYER * L, j = L >> 1;
#define ws wsp(args)
#define X ((float*)(wsp(args) + WS_X))
#define XB ((bf16*)(wsp(args) + WS_XB + (size_t)(L & 1) * SZ_X16))
#define XBN ((bf16*)(wsp(args) + WS_XB + (size_t)((L + 1) & 1) * SZ_X16))
#define Y ((float*)(wsp(args) + WS_Y))
        if ((L & 1) == 0) {
            SITE(1, base + 0,
                pg8::Gemm g{XB, (const bf16*)(ws + WS_WIN + j * SZ_WIN), M, EVEN_IN, D, D, 0ull, 0ull, 0};
                pg8::StaticOrder S; S.init(M, EVEN_IN, G, (int)blockIdx.x);
                EpiEvenIn E{(bf16*)(ws + WS_U), (bf16*)(ws + WS_ZV), (float*)(ws + WS_QF), outp(args), j};
                pg8::gemm_phase<EpiEvenIn, pg8::StaticOrder, true>(lds, g, S, E););
            SITE(2, base + 1, const Ctx c = make_ctx(lds); even_mix_phase(args, j, c););
            SITE(3, base + 7,
                pg8::Gemm g{(const bf16*)(ws + WS_AO), (const bf16*)(ws + WS_WOE + j * SZ_W22), M, D, D, D, 0ull, 0ull, 0};
                pg8::SplitOrder S; S.init(D, G, (int)blockIdx.x);
                EpiResid E{X, Y, (float*)(ws + WS_SLAB)};
                pg8::gemm_phase<EpiResid, pg8::SplitOrder, true>(lds, g, S, E););
        } else {
            SITE(4, base + 0, const Ctx c = make_ctx(lds); mix_phase(args, j, c););
            SITE(5, base + 1,
                pg8::Gemm g{(const bf16*)(ws + WS_MIX), (const bf16*)(ws + WS_W1T + j * SZ_W1T), M, N_O1, D, D, 0x2222222200000000ull, 0x0000534133333333ull, (size_t)M * D};
                pg8::StaticOrder S; S.init(M, N_O1, G, (int)blockIdx.x);
                EpiO1 E{(float*)(ws + WS_R), (float*)(ws + WS_K), (float*)(ws + (j == 0 ? WS_V1 : WS_V3)), (bf16*)(ws + WS_H1)};
                pg8::gemm_phase<EpiO1, pg8::StaticOrder, true>(lds, g, S, E););
            SITE(6, base + 2,
                pg8::Gemm g{(const bf16*)(ws + WS_H1), (const bf16*)(ws + WS_W2T + j * SZ_W2T), M, N_O2, 256, 512, 0ull, 0x1111111100000000ull, 256};
                pg8::StaticOrder S; S.init(M, N_O2, G, (int)blockIdx.x);
                EpiO2 E{(float*)(ws + WS_WD), (bf16*)(ws + WS_AA), (bf16*)(ws + WS_VG), (bf16*)(ws + WS_GG), inp(args, I_W0) + (size_t)j * D, inp(args, I_A0) + (size_t)j * D, j == 0 ? nullptr : inp(args, I_V0)};
                pg8::gemm_phase<EpiO2, pg8::StaticOrder, true>(lds, g, S, E););
            SITE(7, base + 3, const Ctx c = make_ctx(lds); chunk_phase(args, j, c););
            SITE(16, base + 4, const Ctx c = make_ctx(lds); chain_phase(args, j, c););
            if (SEL(7) && IN(base + 5)) { const Ctx c = make_ctx(lds); ychunk_phase(args, c); SEAM(); }
            SITE(8, base + 6, const Ctx c = make_ctx(lds); post_phase(args, j, c););
            SITE(9, base + 7,
                pg8::Gemm g{(const bf16*)(ws + WS_YG), (const bf16*)(ws + WS_WOC + j * SZ_W22), M, D, D, D, 0ull, 0ull, 0};
                pg8::SplitOrder S; S.init(D, G, (int)blockIdx.x);
                EpiResid E{X, Y, (float*)(ws + WS_SLAB)};
                pg8::gemm_phase<EpiResid, pg8::SplitOrder, true>(lds, g, S, E););
        }
        SITE(10, base + 8, const Ctx c = make_ctx(lds); ln_phase(Y, (const float*)(wsp(args) + WS_SLAB), inp(args, I_LN1G) + (size_t)L * D, inp(args, I_LN1B) + (size_t)L * D, X, XB, c););
        SITE(11, base + 9,
            pg8::Gemm g{XB, (const bf16*)(ws + WS_FIN + L * SZ_FIN), M, 2 * DFF, D, D, 0ull, 0ull, 0};
            pg8::StaticOrder S; S.init(M, 2 * DFF, G, (int)blockIdx.x);
            EpiFfnIn E{(bf16*)(ws + WS_HG), (bf16*)(ws + WS_HU), outp(args), L};
            pg8::gemm_phase<EpiFfnIn, pg8::StaticOrder, true>(lds, g, S, E););
        SITE(12, base + 10,
            { const Ctx c = make_ctx(lds); act_phase(args, L, c); }
            __syncthreads();
            pg8::Gemm g{(const bf16*)(ws + WS_PB + L * SZ_PB), (const bf16*)(ws + WS_WP + L * SZ_WP), M, D, PLE, PLE, 0ull, 0ull, 0};
            pg8::StaticOrder S; S.init(M, D, G, (int)blockIdx.x);
            EpiF32 E{(float*)(ws + WS_PPF), D};
            pg8::gemm_phase<EpiF32, pg8::StaticOrder, true>(lds, g, S, E););
        SITE(13, base + 11,
            pg8::Gemm g{(const bf16*)(ws + WS_ACT), (const bf16*)(ws + WS_FOUT + L * SZ_FOUT), M, D, DFF, DFF, 0ull, 0ull, 0};
            pg8::SplitOrder S; S.init(DFF, G, (int)blockIdx.x);
            EpiResid E{X, Y, (float*)(ws + WS_SLAB)};
            pg8::gemm_phase<EpiResid, pg8::SplitOrder, true>(lds, g, S, E););
        SITE(14, base + 12, const Ctx c = make_ctx(lds); ln_phase(Y, (const float*)(wsp(args) + WS_SLAB), inp(args, I_LN2G) + (size_t)L * D, inp(args, I_LN2B) + (size_t)L * D, X, XB, c););
        if (SEL(15) && IN(base + 13)) {
            pg8::Gemm g{XB, (const bf16*)(ws + WS_WG + L * SZ_W22), M, D, D, D, 0ull, 0ull, 0};
            pg8::StaticOrder S; S.init(M, D, G, (int)blockIdx.x);
            EpiPle E{X, XBN, (const float*)(ws + WS_PPF), L == 3 ? outp(args) : nullptr};
            pg8::gemm_phase<EpiPle, pg8::StaticOrder, true>(lds, g, S, E);
            SEAM();
        }
    }
#undef IN
#undef SEAM
#undef ws
#undef X
#undef XB
#undef XBN
#undef Y
}

extern "C" void kernel_launch(void* const* d_in, const int* in_sizes, int n_in, void* d_out, int out_size, void* d_ws, size_t ws_size, hipStream_t stream) {
    static int grid = 0;
    if (grid == 0) {
        if (n_in != N_IN || out_size != (int)OUT_END || ws_size < WS_END) { fprintf(stderr, "kernel_launch: unexpected problem shape (n_in %d, out %d, ws %zu; need %d, %zu, %zu)\n", n_in, out_size, ws_size, (int)N_IN, (size_t)OUT_END, (size_t)WS_END); grid = -1; return; }
        int dev = 0, cus = 0, per_cu = 0;
        if (hipGetDevice(&dev) != hipSuccess || hipDeviceGetAttribute(&cus, hipDeviceAttributeMultiprocessorCount, dev) != hipSuccess) { grid = -1; return; }
        if (hipFuncSetAttribute((const void*)fwd_kernel, hipFuncAttributeMaxDynamicSharedMemorySize, LDS_BYTES) != hipSuccess) { fprintf(stderr, "kernel_launch: hipFuncSetAttribute failed\n"); grid = -1; return; }
        if (hipOccupancyMaxActiveBlocksPerMultiprocessor(&per_cu, (const void*)fwd_kernel, NTHREADS, LDS_BYTES) != hipSuccess || per_cu < 1) fprintf(stderr, "kernel_launch: occupancy query reports %d\n", per_cu);
        (void)hipGetLastError();
        grid = cus;
    }
    if (grid < 0) return;
    (void)in_sizes;
    if (hipMemsetAsync((char*)d_ws + WS_CTL, 0, CTL_ZERO_BYTES, stream) != hipSuccess) return;
    Args a{};
    for (int i = 0; i < N_IN; ++i) a.in[i] = (const float*)d_in[i];
    a.out = (float*)d_out; a.ws = (unsigned char*)d_ws;
#if MK_ONE_LAUNCH
    a.ph_lo = 0; a.ph_hi = N_PHASES;
    hipLaunchKernelGGL(fwd_kernel, dim3(grid), dim3(NTHREADS), LDS_BYTES, stream, a);
#else
    for (int ph = 0; ph < N_PHASES; ++ph) { if (!phase_exists(ph)) continue; a.ph_lo = ph; a.ph_hi = ph + 1;
        hipLaunchKernelGGL(fwd_kernel, dim3(grid), dim3(NTHREADS), LDS_BYTES, stream, a); }
#endif
}
```
